# Optimizing an MI355X kernel written in HIP

```python
import math
import jax, jax.numpy as jnp
from jax import lax
import numpy as np

D_MODEL = 2048
BATCH = 4
SEQ = 4096
DEPTH = 2

CTX_LEN = 256
GRID_W = 64
MIX_WIDTH = D_MODEL
F_GROUPS = 4
F_WIDTH = MIX_WIDTH // 4
F_GDIM = F_WIDTH // F_GROUPS
POOL_WINDOWS = (2, 4, 8, 16)
P_GROUPS = len(POOL_WINDOWS)
P_WIDTH = MIX_WIDTH // 4
P_GDIM = P_WIDTH // P_GROUPS
RET_WIDTH = MIX_WIDTH // 2
RET_HEADS = 8
RET_DK = RET_WIDTH // RET_HEADS
RET_CHUNK = 128
N_BRANCH = 3
ROPE_BASE = 10000.0
EPS = 1e-6

F_X_OFF = 0
F_G_OFF = F_X_OFF + F_WIDTH
P_X_OFF = F_G_OFF + F_WIDTH
P_G_OFF = P_X_OFF + P_WIDTH
R_Q_OFF = P_G_OFF + P_WIDTH
R_K_OFF = R_Q_OFF + RET_WIDTH
R_V_OFF = R_K_OFF + RET_WIDTH
R_G_OFF = R_V_OFF + RET_WIDTH
MG_OFF = R_G_OFF + RET_WIDTH
IN_WIDTH = MG_OFF + N_BRANCH * D_MODEL

kernel_name = "hybrid_fourier_pool_retention_dit"


def rms_norm(x, g):
    xf = x.astype(jnp.float32)
    y = xf * lax.rsqrt(jnp.mean(xf * xf, axis=-1, keepdims=True) + EPS)
    return (y * g.astype(jnp.float32)).astype(x.dtype)


def head_rms(o):
    return o * lax.rsqrt(jnp.mean(o * o, axis=-1, keepdims=True) + EPS)


def to_heads(u):
    B, N, _ = u.shape
    return u.reshape(B, N, RET_HEADS, RET_DK).transpose(0, 2, 1, 3).astype(jnp.float32)


def rope_axis(x, pos):
    nf = x.shape[-1] // 2
    inv = ROPE_BASE ** (-jnp.arange(nf, dtype=jnp.float32) / nf)
    ang = pos.astype(jnp.float32)[:, None] * inv[None, :]
    cos, sin = jnp.cos(ang), jnp.sin(ang)
    x1, x2 = x[..., :nf], x[..., nf:]
    return jnp.concatenate([x1 * cos - x2 * sin, x1 * sin + x2 * cos], axis=-1)


def rope_2d(x, rows, cols):
    h = x.shape[-1] // 2
    return jnp.concatenate([rope_axis(x[..., :h], rows), rope_axis(x[..., h:], cols)], axis=-1)


def fourier_mix(u, w_fourier):
    B, N, _ = u.shape
    ug = u.astype(jnp.float32).reshape(B, N, F_GROUPS, F_GDIM)
    mixed = jnp.fft.fft2(ug, axes=(1, 3), norm="ortho").real
    y = jnp.einsum("bngc,gcd->bngd", mixed, w_fourier.astype(jnp.float32))
    return y.reshape(B, N, F_WIDTH).astype(u.dtype)


def pool_mix(u, w_pool, pool_scale):
    B, N, _ = u.shape
    uf = u.astype(jnp.float32).reshape(B, N, P_GROUPS, P_GDIM)
    cs = jnp.concatenate([jnp.zeros((B, 1, P_GROUPS, P_GDIM), jnp.float32), jnp.cumsum(uf, axis=1)], axis=1)
    t = jnp.arange(N)
    outs = []
    for g, w in enumerate(POOL_WINDOWS):
        lo = jnp.clip(t - w // 2, 0, N)
        hi = jnp.clip(t + w // 2, 0, N)
        cs_g = cs[:, :, g]
        cnt = (hi - lo).astype(jnp.float32)[None, :, None]
        outs.append((cs_g[:, hi] - cs_g[:, lo]) / cnt - uf[:, :, g])
    pooled = jnp.stack(outs, axis=2)
    y = jnp.einsum("bngc,gcd->bngd", pooled, w_pool.astype(jnp.float32)).reshape(B, N, P_WIDTH)
    return (y * pool_scale.astype(jnp.float32)).astype(u.dtype)


def retention_scan(q, k, v, log_gamma, s0):
    B, H, N, d = q.shape
    C = RET_CHUNK
    nc = N // C
    qc = q.reshape(B, H, nc, C, d)
    kc = k.reshape(B, H, nc, C, d)
    vc = v.reshape(B, H, nc, C, d)
    i = jnp.arange(C, dtype=jnp.float32)
    lg = log_gamma[:, None]
    diff = i[:, None] - i[None, :]
    mask = jnp.where(diff >= 0, jnp.exp(lg[:, :, None] * jnp.maximum(diff, 0.0)), 0.0)
    scores = jnp.einsum("bhnid,bhnjd->bhnij", qc, kc) * mask[None, :, None]
    o_intra = jnp.einsum("bhnij,bhnje->bhnie", scores, vc)
    k_dec = kc * jnp.exp(lg * (C - 1 - i))[None, :, None, :, None]
    kv = jnp.einsum("bhnjd,bhnje->nbhde", k_dec, vc)
    chunk_decay = jnp.exp(log_gamma * C)[None, :, None, None]

    def step(s, kv_n):
        return chunk_decay * s + kv_n, s

    s_final, s_prev = lax.scan(step, s0, kv)
    q_dec = qc * jnp.exp(lg * (i + 1))[None, :, None, :, None]
    o_cross = jnp.einsum("bhnid,nbhde->bhnie", q_dec, s_prev)
    return (o_intra + o_cross).reshape(B, H, N, d), s_final


def retention_final_state(k, v, log_gamma):
    N = k.shape[2]
    w = jnp.exp(log_gamma[:, None] * (N - 1 - jnp.arange(N, dtype=jnp.float32))[None, :])
    return jnp.einsum("bhnd,hn,bhne->bhde", k, w, v)


def hybrid_mixer(h, w_in, w_fourier, w_pool, pool_scale, log_gamma,
                 w_up_fourier, w_up_pool, w_up_ret, w_out, pos, s0_fwd, s0_bwd):
    B, N, _ = h.shape
    proj = h @ w_in
    f_x, f_g = proj[..., F_X_OFF:F_G_OFF], proj[..., F_G_OFF:P_X_OFF]
    p_x, p_g = proj[..., P_X_OFF:P_G_OFF], proj[..., P_G_OFF:R_Q_OFF]
    q = to_heads(proj[..., R_Q_OFF:R_K_OFF]) * (RET_DK ** -0.5)
    k = to_heads(proj[..., R_K_OFF:R_V_OFF])
    v = to_heads(proj[..., R_V_OFF:R_G_OFF])
    r_g = proj[..., R_G_OFF:MG_OFF]
    gate_logits = proj[..., MG_OFF:].reshape(B, N, N_BRANCH, D_MODEL)
    if pos is not None:
        q = rope_2d(q, pos[0], pos[1])
        k = rope_2d(k, pos[0], pos[1])
    y_f = (fourier_mix(f_x, w_fourier) * jax.nn.silu(f_g)) @ w_up_fourier
    y_p = (pool_mix(p_x, w_pool, pool_scale) * jax.nn.silu(p_g)) @ w_up_pool
    o_f, s_f = retention_scan(q, k, v, log_gamma[0], s0_fwd)
    o_b, s_b = retention_scan(jnp.flip(q, 2), jnp.flip(k, 2), jnp.flip(v, 2), log_gamma[1], s0_bwd)
    o = head_rms(o_f + jnp.flip(o_b, 2)).transpose(0, 2, 1, 3).reshape(B, N, RET_WIDTH).astype(h.dtype)
    y_r = (o * jax.nn.silu(r_g)) @ w_up_ret
    g = jax.nn.sigmoid(gate_logits.astype(jnp.float32)).astype(h.dtype)
    merged = g[:, :, 0] * y_f + g[:, :, 1] * y_p + g[:, :, 2] * y_r
    return (merged @ w_out).astype(h.dtype), s_f, s_b


def setup_inputs(seed: int = 0) -> dict:
    key = jax.random.key(seed)
    ks = jax.random.split(key, 20)
    f32 = jnp.float32
    D = D_MODEL

    def nrm(k, shape, scale):
        return jax.random.normal(k, shape, f32) * scale

    base_decay = (5.0 + jnp.arange(RET_HEADS, dtype=f32)) * math.log(2.0)
    return {
        "x": nrm(ks[0], (BATCH, SEQ, D), 1.0),
        "c": nrm(ks[1], (BATCH, D), 1.0),
        "ctx": nrm(ks[2], (BATCH, CTX_LEN, D), 1.0),
        "c_ctx": nrm(ks[3], (D,), 1.0),
        "w_ada": nrm(ks[4], (DEPTH, D, 3 * D), D ** -0.5),
        "b_ada": nrm(ks[5], (DEPTH, 3 * D), 0.01),
        "norm_g": 1.0 + nrm(ks[6], (DEPTH, D), 0.02),
        "w_in": nrm(ks[7], (DEPTH, D, IN_WIDTH), D ** -0.5),
        "w_fourier": nrm(ks[8], (DEPTH, F_GROUPS, F_GDIM, F_GDIM), F_GDIM ** -0.5),
        "w_pool": nrm(ks[9], (DEPTH, P_GROUPS, P_GDIM, P_GDIM), P_GDIM ** -0.5),
        "pool_scale": 1.0 + nrm(ks[10], (DEPTH, P_WIDTH), 0.02),
        "ret_decay_logit": base_decay[None, None, :] + nrm(ks[11], (DEPTH, 2, RET_HEADS), 0.1),
        "w_up_fourier": nrm(ks[12], (DEPTH, F_WIDTH, D), F_WIDTH ** -0.5),
        "w_up_pool": nrm(ks[13], (DEPTH, P_WIDTH, D), P_WIDTH ** -0.5),
        "w_up_ret": nrm(ks[14], (DEPTH, RET_WIDTH, D), RET_WIDTH ** -0.5),
        "w_out": nrm(ks[15], (DEPTH, D, D), D ** -0.5),
        "final_norm_g": 1.0 + nrm(ks[16], (D,), 0.02),
    }


def reference(x, c, ctx, c_ctx, w_ada, b_ada, norm_g, w_in, w_fourier, w_pool, pool_scale,
              ret_decay_logit, w_up_fourier, w_up_pool, w_up_ret, w_out, final_norm_g):
    B, N, _ = x.shape
    ROWS = N // GRID_W
    grid_r, grid_c = jnp.meshgrid(jnp.arange(ROWS), jnp.arange(GRID_W), indexing="ij")
    pos = (grid_r.reshape(-1), grid_c.reshape(-1))
    silu_c = jax.nn.silu(c)
    silu_cc = jax.nn.silu(c_ctx)
    s_zero = jnp.zeros((ctx.shape[0], RET_HEADS, RET_DK, RET_DK), jnp.float32)
    for l in range(DEPTH):
        last = l == DEPTH - 1
        mod = silu_c @ w_ada[l] + b_ada[l]
        shift, scale, gate = jnp.split(mod[:, None, :], 3, axis=-1)
        mod_c = silu_cc @ w_ada[l] + b_ada[l]
        shift_c, scale_c, gate_c = jnp.split(mod_c, 3, axis=-1)
        log_gamma = jax.nn.log_sigmoid(ret_decay_logit[l].astype(jnp.float32))
        h = rms_norm(x, norm_g[l]) * (1.0 + scale) + shift
        hc = rms_norm(ctx, norm_g[l]) * (1.0 + scale_c) + shift_c
        if last:
            kv_c = hc @ w_in[l][:, R_K_OFF:R_G_OFF]
            k_c = to_heads(kv_c[..., :RET_WIDTH])
            v_c = to_heads(kv_c[..., RET_WIDTH:])
            s_f = retention_final_state(k_c, v_c, log_gamma[0])
            s_b = retention_final_state(jnp.flip(k_c, 2), jnp.flip(v_c, 2), log_gamma[1])
        else:
            y_c, s_f, s_b = hybrid_mixer(hc, w_in[l], w_fourier[l], w_pool[l], pool_scale[l], log_gamma,
                                         w_up_fourier[l], w_up_pool[l], w_up_ret[l], w_out[l],
                                         None, s_zero, s_zero)
        y, _, _ = hybrid_mixer(h, w_in[l], w_fourier[l], w_pool[l], pool_scale[l], log_gamma,
                               w_up_fourier[l], w_up_pool[l], w_up_ret[l], w_out[l],
                               pos, s_f, s_b)
        x = x + gate * y
        if not last:
            ctx = ctx + gate_c * y_c
    return rms_norm(x, final_norm_g)
```

```cpp
#include <hip/hip_runtime.h>
#include <hip/hip_cooperative_groups.h>
#include <cstdio>
#include <cstdint>
namespace cg = cooperative_groups;

#define LAS __attribute__((address_space(3)))
typedef unsigned short bf16_t;
typedef short bf16x8 __attribute__((ext_vector_type(8)));
typedef float f32x4 __attribute__((ext_vector_type(4)));
typedef float f32x2 __attribute__((ext_vector_type(2)));
typedef unsigned u32x4 __attribute__((ext_vector_type(4)));
typedef unsigned u32x2 __attribute__((ext_vector_type(2)));

constexpr int D = 2048, NB = 4, SEQ = 4096, CTXL = 256, DEPTH = 2;
constexpr int MLAT = NB * SEQ, MCTX = NB * CTXL, MTOT = MLAT + MCTX;
constexpr int INW = 12288;
constexpr int LDX = 2048 + 64;
constexpr int OFF_FX = 0, OFF_FG = 512, OFF_PX = 1024, OFF_PG = 1536, OFF_Q = 2048, OFF_K = 3072, OFF_V = 4096, OFF_RG = 5120, OFF_MG = 6144;
constexpr int NH = 8, DK = 128, CH = 128;
constexpr int NCH_L = SEQ / CH, NCH_C = CTXL / CH, NCH = NCH_L + NCH_C;
constexpr float EPS = 1e-6f;
constexpr float TWO_PI = 6.283185307179586f;

constexpr size_t MiB = 1u << 20;
constexpr size_t WS_MOD = 0;
constexpr size_t WS_LG = 248 * 1024;
constexpr size_t WS_WCST = 256 * 1024;
constexpr size_t WS_WPT = 512 * 1024;
constexpr size_t WS_A1 = 640 * 1024;
constexpr size_t WS_A3 = 656 * 1024;
constexpr size_t WS_BAR = 704 * 1024;
constexpr size_t WS_WIN = 1 * MiB;
constexpr size_t WS_WUP = 51 * MiB;
constexpr size_t WS_WOUT = 60 * MiB;
constexpr size_t WS_XN = 69 * MiB;
constexpr size_t WS_PROJ = 140 * MiB;
constexpr size_t WS_XFIN = WS_PROJ;
constexpr size_t WS_CTX1 = 548 * MiB;
constexpr size_t WS_KVT = 556 * MiB;
constexpr size_t WS_MERGED = WS_KVT;
constexpr size_t WS_SST = 627 * MiB;
constexpr size_t WS_TP = 695 * MiB;
constexpr size_t WS_END = 730 * MiB;
static_assert(WS_WIN + (size_t)12288 * LDX * 2 <= WS_WUP && WS_WUP + (size_t)2048 * LDX * 2 <= WS_WOUT && WS_WOUT + (size_t)2048 * LDX * 2 <= WS_XN && WS_XN + (size_t)MTOT * LDX * 2 <= WS_PROJ
              && WS_PROJ + (size_t)MTOT * INW * 2 <= WS_CTX1 && WS_MERGED + (size_t)MTOT * LDX * 2 <= WS_SST && WS_KVT + (size_t)32 * 34 * 2 * 16384 * 2 <= WS_SST && WS_SST + (size_t)32 * 34 * 2 * 16384 * 2 <= WS_TP
              && WS_TP + ((size_t)4 * 64 * 512 * 128 + (size_t)4 * 4 * 512 * 128) * 2 <= WS_END, "d_ws map");
constexpr size_t TP_CTX_OFF = (size_t)4 * 64 * 512 * 128;

constexpr int LDS_BYTES = 147456;
constexpr int WGM_IN = 4, WGM_UP = 4, WGM_OUT = 4;

__device__ __forceinline__ unsigned f2bf(float f) { unsigned u = __float_as_uint(f); return (u + 0x7fffu + ((u >> 16) & 1u)) >> 16; }
__device__ __forceinline__ unsigned pk2(float lo, float hi) { return f2bf(lo) | (f2bf(hi) << 16); }
__device__ __forceinline__ float bflo(unsigned w) { return __uint_as_float(w << 16); }
__device__ __forceinline__ float bfhi(unsigned w) { return __uint_as_float(w & 0xffff0000u); }
__device__ __forceinline__ float bf2f(bf16_t b) { return __uint_as_float(((unsigned)b) << 16); }
__device__ __forceinline__ unsigned cvt_pk_bf16(float lo, float hi) { unsigned r; asm volatile("v_cvt_pk_bf16_f32 %0, %1, %2" : "=v"(r) : "v"(lo), "v"(hi)); return r; }
__device__ __forceinline__ float sigmoidf_(float x) { return __builtin_amdgcn_rcpf(1.0f + __expf(-x)); }
__device__ __forceinline__ f32x4 mfma16(bf16x8 a, bf16x8 b, f32x4 c) { return __builtin_amdgcn_mfma_f32_16x16x32_bf16(a, b, c, 0, 0, 0); }
__device__ __forceinline__ bf16x8 as_bf16x8(u32x4 v) { return __builtin_bit_cast(bf16x8, v); }
__device__ __forceinline__ float sin_rev(float r) { return __builtin_amdgcn_sinf(r); }
__device__ __forceinline__ float cos_rev(float r) { return __builtin_amdgcn_cosf(r); }
#define LDS_WAIT() asm volatile("s_waitcnt lgkmcnt(0)" ::: "memory")
__device__ __forceinline__ void unpack8(const u32x4 v, float (&f)[8]) {
    f[0] = bflo(v.x); f[1] = bfhi(v.x); f[2] = bflo(v.y); f[3] = bfhi(v.y); f[4] = bflo(v.z); f[5] = bfhi(v.z); f[6] = bflo(v.w); f[7] = bfhi(v.w);
}
__device__ __forceinline__ u32x4 pack8(const float (&f)[8]) { u32x4 w; w.x = pk2(f[0], f[1]); w.y = pk2(f[2], f[3]); w.z = pk2(f[4], f[5]); w.w = pk2(f[6], f[7]); return w; }

namespace pg8 {
constexpr int BM = 256, BK = 64, HALF = 128, HTB = HALF * BK * 2, STAGE_BYTES = 8 * HTB, NXCD = 8;
__device__ __forceinline__ int lds_byte(int r, int c) { const int st = (r >> 4) * 2 + (c >> 5), rr = r & 15, cc = c & 31, ob = rr * 64 + cc * 2; return st * 1024 + (ob ^ (((ob >> 9) & 1) << 5)); }
__device__ __forceinline__ void stage_rc(int b, int& R, int& C) { const int st = b / 1024, sb = b % 1024, swz = sb ^ (((sb >> 9) & 1) << 5); R = (st >> 1) * 16 + swz / 64; C = (st & 1) * 32 + (swz % 64) / 2; }
__device__ __forceinline__ int perm32(int rho) { const int n = rho >> 4, i = rho & 15; return 8 * (i >> 2) + 4 * n + (i & 3); }

struct Unit { int pm, pn; };
struct Gemm { const bf16_t* A; const bf16_t* Bt; int lda, ldb, M, N, K; };

struct StaticOrder {
    int nM, nN, nwg, G, c, WGM, xpm, xpn, xn;
    __device__ void init(int M, int N, int G_, int c_, int wgm) { nM = M / BM; nN = N / BM; nwg = nM * nN; G = G_; c = c_; WGM = wgm; xn = 0; xpm = 0; xpn = 0; }
    __device__ void add_extra(int pm0, int pn0, int n) { xpm = pm0; xpn = pn0; xn = n; }
    __device__ bool next(int i, Unit& u) const {
        const long L = (long)i * G + c;
        if (L >= nwg) { const int e = (int)(L - nwg); if (e >= xn) return false; u.pm = xpm + (e & 3); u.pn = xpn + (e >> 2); return true; }
        int wgid = (int)L; { const int q = nwg / NXCD, r = nwg % NXCD, xcd = wgid % NXCD, off = wgid / NXCD; wgid = (xcd < r ? xcd * (q + 1) : r * (q + 1) + (xcd - r) * q) + off; }
        const int nig = WGM * nN, gid = wgid / nig, fm = gid * WGM, gsz = (nM - fm) < WGM ? (nM - fm) : WGM;
        u.pm = fm + ((wgid % nig) % gsz); u.pn = (wgid % nig) / gsz; return true;
    }
};

template <class Epi>
__device__ __forceinline__ void gemm_phase(LAS unsigned char* lds, const Gemm g, const StaticOrder& S, const Epi& E) {
    int tid = threadIdx.x; asm volatile("" : "+v"(tid));
    const int wid = __builtin_amdgcn_readfirstlane(tid >> 6), lane = tid & 63, wr = wid >> 2, wc = wid & 3, fr = lane & 15, fq = lane >> 4;
    const int K = g.K, nt = K / BK;
    unsigned voffA[2], voffB[2];
#pragma unroll
    for (int i = 0; i < 2; ++i) { int R, C; stage_rc(tid * 16 + i * 8192, R, C); const int Rb = Epi::PERM ? ((R & ~31) + perm32(R & 31)) : R;
        voffA[i] = (unsigned)(R * g.lda + C) * 2u; voffB[i] = (unsigned)(Rb * g.ldb + C) * 2u; }
    const size_t kstep = (size_t)(BK * 2);
    const size_t hstepA = (size_t)HALF * g.lda * 2, hstepB = (size_t)HALF * g.ldb * 2;
    const size_t tstepA = 2 * hstepA, tstepB = 2 * hstepB;
    const unsigned ldsw = (unsigned)wid * 1024u;
    const int aoff = lds_byte(wr * 64 + fr, fq * 8), boff = lds_byte(wc * 32 + fr, fq * 8);
#define PG8_SA(b, h) (((b) * 2 + (h)) * HTB)
#define PG8_SB(b, h) ((4 + (b) * 2 + (h)) * HTB)
#define PG8_STAGE(bufoff, gbase, voff) do { _Pragma("unroll") for (int _i = 0; _i < 2; ++_i) \
        __builtin_amdgcn_global_load_lds((const unsigned*)((const char*)(gbase) + (voff)[_i]), (LAS unsigned*)(lds + (bufoff) + ldsw + _i * 8192), 16, 0, 0); } while (0)
#define PG8_LDA(dst, b, h) do { _Pragma("unroll") for (int m = 0; m < 4; ++m) _Pragma("unroll") for (int k = 0; k < 2; ++k) dst[m][k] = *(const LAS bf16x8*)(lds + PG8_SA(b, h) + aoff + m * 2048 + k * 1024); } while (0)
#define PG8_LDB(dst, b, h) do { _Pragma("unroll") for (int n = 0; n < 2; ++n) _Pragma("unroll") for (int k = 0; k < 2; ++k) dst[n][k] = *(const LAS bf16x8*)(lds + PG8_SB(b, h) + boff + n * 2048 + k * 1024); } while (0)
#define PG8_MMA(ai, bj, At, Bt) do { __builtin_amdgcn_s_setprio(1); _Pragma("unroll") for (int m = 0; m < 4; ++m) _Pragma("unroll") for (int n = 0; n < 2; ++n) _Pragma("unroll") for (int k = 0; k < 2; ++k) \
        acc[ai][bj][m][n] = __builtin_amdgcn_mfma_f32_16x16x32_bf16(Bt[n][k], At[m][k], acc[ai][bj][m][n], 0, 0, 0); __builtin_amdgcn_s_setprio(0); } while (0)
#define PG8_WAIT_V(n) asm volatile("s_waitcnt vmcnt(" #n ")" ::: "memory")
#define PG8_WAIT_L(n) asm volatile("s_waitcnt lgkmcnt(" #n ")" ::: "memory")
#define PG8_BAR __builtin_amdgcn_s_barrier()
#define PG8_SCHED __builtin_amdgcn_sched_barrier(0)
    Unit cur, nxt; int ui = 0;
    if (!S.next(0, cur)) return;
    f32x4 acc[2][2][4][2];
#pragma unroll
    for (int a = 0; a < 2; ++a)
#pragma unroll
        for (int b = 0; b < 2; ++b)
#pragma unroll
            for (int m = 0; m < 4; ++m)
#pragma unroll
                for (int n = 0; n < 2; ++n) acc[a][b][m][n] = (f32x4){0.f, 0.f, 0.f, 0.f};
    bf16x8 At[4][2], B0[2][2], B1[2][2];
    const char* cA = (const char*)g.A + (size_t)cur.pm * tstepA; const char* cB = (const char*)g.Bt + (size_t)cur.pn * tstepB;
    PG8_STAGE(PG8_SB(0, 0), cB, voffB); PG8_STAGE(PG8_SB(0, 1), cB + hstepB, voffB); PG8_STAGE(PG8_SA(0, 0), cA, voffA); PG8_STAGE(PG8_SA(0, 1), cA + hstepA, voffA);
    if (wr == 1) PG8_BAR;
    PG8_WAIT_V(2); PG8_BAR;
    PG8_STAGE(PG8_SB(1, 0), cB + kstep, voffB); PG8_STAGE(PG8_SA(1, 0), cA + kstep, voffA); PG8_STAGE(PG8_SB(1, 1), cB + hstepB + kstep, voffB);
    PG8_WAIT_V(6); PG8_BAR;
    for (;;) {
        const bool has_next = S.next(ui + 1, nxt);
        const char* nA = has_next ? (const char*)g.A + (size_t)nxt.pm * tstepA : cA; const char* nB = has_next ? (const char*)g.Bt + (size_t)nxt.pn * tstepB : cB;
#pragma unroll 1
        for (int seg = 0; seg < (Epi::MIDK ? 3 : 1); ++seg) {
        const int t0 = Epi::MIDK ? seg * 8 : 0, t1 = Epi::MIDK ? (seg == 2 ? nt : seg * 8 + 8) : nt;
        if constexpr (Epi::MIDK) { if (seg > 0) { PG8_SCHED;
            asm volatile("s_cmp_lg_u32 %0, 0\n\ts_cbranch_scc1 1f\n\ts_barrier\n1:" :: "s"(wr) : "memory", "scc");
            E.mid(acc, cur, t0, wr, wc, fr, fq);
            asm volatile("s_cmp_lg_u32 %0, 1\n\ts_cbranch_scc1 1f\n\ts_barrier\n1:" :: "s"(wr) : "memory", "scc");
            PG8_SCHED; } }
#pragma unroll 1
        for (int t = t0; t < t1; t += 2) {
            const bool last = (t == nt - 2);
            const char* a1 = cA + (size_t)(t + 1) * kstep;
            const char* a2 = last ? nA : cA + (size_t)(t + 2) * kstep; const char* b2 = last ? nB : cB + (size_t)(t + 2) * kstep;
            const char* a3 = a2 + kstep; const char* b3 = b2 + kstep;
            PG8_LDB(B0, 0, 0); PG8_LDB(B1, 0, 1); PG8_SCHED; PG8_LDA(At, 0, 0); PG8_STAGE(PG8_SA(1, 1), a1 + hstepA, voffA);
            PG8_WAIT_V(8); PG8_WAIT_L(0); PG8_BAR; PG8_MMA(0, 0, At, B0); PG8_MMA(0, 1, At, B1); PG8_BAR; PG8_SCHED;
            PG8_LDA(At, 0, 1); PG8_STAGE(PG8_SB(0, 0), b2, voffB); PG8_STAGE(PG8_SB(0, 1), b2 + hstepB, voffB); PG8_STAGE(PG8_SA(0, 0), a2, voffA);
            PG8_WAIT_V(8); PG8_WAIT_L(0); PG8_BAR; PG8_MMA(1, 0, At, B0); PG8_MMA(1, 1, At, B1); PG8_BAR; PG8_SCHED;
            PG8_LDB(B0, 1, 0); PG8_LDB(B1, 1, 1); PG8_SCHED; PG8_LDA(At, 1, 0); PG8_STAGE(PG8_SA(0, 1), a2 + hstepA, voffA);
            PG8_WAIT_V(8); PG8_WAIT_L(0); PG8_BAR; PG8_MMA(0, 0, At, B0); PG8_MMA(0, 1, At, B1); PG8_BAR; PG8_SCHED;
            PG8_LDA(At, 1, 1); PG8_STAGE(PG8_SB(1, 0), b3, voffB); PG8_STAGE(PG8_SB(1, 1), b3 + hstepB, voffB); PG8_STAGE(PG8_SA(1, 0), a3, voffA);
            PG8_WAIT_V(8); PG8_WAIT_L(0); PG8_BAR; PG8_MMA(1, 0, At, B0); PG8_MMA(1, 1, At, B1); PG8_BAR; PG8_SCHED;
        }
        }
        if constexpr (Epi::ALIGN) { if (wr == 0) PG8_BAR; }
        E(acc, cur, wr, wc, fr, fq);
        if (!has_next) break;
#pragma unroll
        for (int a = 0; a < 2; ++a)
#pragma unroll
            for (int b = 0; b < 2; ++b)
#pragma unroll
                for (int m = 0; m < 4; ++m)
#pragma unroll
                    for (int n = 0; n < 2; ++n) acc[a][b][m][n] = (f32x4){0.f, 0.f, 0.f, 0.f};
        cur = nxt; cA = nA; cB = nB; ++ui;
        if constexpr (Epi::ALIGN) { if (wr == 1) PG8_BAR; }
    }
    PG8_WAIT_V(0);
    if constexpr (!Epi::ALIGN) { if (wr == 0) PG8_BAR; }
    PG8_BAR;
#undef PG8_SA
#undef PG8_SB
#undef PG8_STAGE
#undef PG8_LDA
#undef PG8_LDB
#undef PG8_MMA
#undef PG8_WAIT_V
#undef PG8_WAIT_L
#undef PG8_BAR
#undef PG8_SCHED
}

struct EpiInProj {
    static constexpr bool PERM = true, MIDK = false, ALIGN = false;
    bf16_t* O;
    __device__ __forceinline__ void mid(f32x4 (&)[2][2][4][2], const Unit&, int, int, int, int, int) const {}
    __device__ __forceinline__ void operator()(const f32x4 (&acc)[2][2][4][2], const Unit& u, int wr, int wc, int fr, int fq) const {
        const int pn = u.pn;
        int act = 0;
        if (pn >= 24) act = 2; else if ((pn >= 2 && pn < 4) || (pn >= 6 && pn < 8) || (pn >= 20)) act = 1; else if (pn >= 8 && pn < 12) act = 3;
        int row0 = u.pm * BM + wr * 64 + fr, col0 = pn * BM + wc * 32 + 8 * fq; asm volatile("" : "+v"(row0), "+v"(col0));
#pragma unroll
        for (int ai = 0; ai < 2; ++ai)
#pragma unroll
            for (int m = 0; m < 4; ++m) { bf16_t* rowp = O + (size_t)(row0 + ai * HALF + m * 16) * INW + col0;
#pragma unroll
                for (int bj = 0; bj < 2; ++bj) { f32x4 v0 = acc[ai][bj][m][0], v1 = acc[ai][bj][m][1];
                    if (act == 1) {
#pragma unroll
                        for (int j = 0; j < 4; ++j) { v0[j] = v0[j] * sigmoidf_(v0[j]); v1[j] = v1[j] * sigmoidf_(v1[j]); } }
                    else if (act == 2) {
#pragma unroll
                        for (int j = 0; j < 4; ++j) { v0[j] = sigmoidf_(v0[j]); v1[j] = sigmoidf_(v1[j]); } }
                    else if (act == 3) { v0 = v0 * 0.08838834764831845f; v1 = v1 * 0.08838834764831845f; }
                    u32x4 w; w.x = cvt_pk_bf16(v0[0], v0[1]); w.y = cvt_pk_bf16(v0[2], v0[3]); w.z = cvt_pk_bf16(v1[0], v1[1]); w.w = cvt_pk_bf16(v1[2], v1[3]);
                    *(u32x4*)(rowp + bj * HALF) = w; } }
    }
};

struct EpiUp {
    static constexpr bool PERM = true, MIDK = true, ALIGN = true;
    const bf16_t* P;
    bf16_t* O;
    __device__ __forceinline__ void mid(f32x4 (&acc)[2][2][4][2], const Unit& u, int t, int wr, int wc, int fr, int fq) const {
        const int br = (t == 8) ? 0 : 1;
        int row0 = u.pm * BM + wr * 64 + fr, col0 = u.pn * BM + wc * 32 + 8 * fq; asm volatile("" : "+v"(row0), "+v"(col0));
#pragma unroll
        for (int ai = 0; ai < 2; ++ai) {
            u32x4 ga[4][2], gb[4][2];
#pragma unroll
            for (int m = 0; m < 4; ++m) { const bf16_t* gp = P + (size_t)(row0 + ai * HALF + m * 16) * INW + OFF_MG + br * 2048 + col0;
#pragma unroll
                for (int bj = 0; bj < 2; ++bj) { ga[m][bj] = *(const u32x4*)(gp + bj * HALF); gb[m][bj] = *(const u32x4*)(gp + 2048 + bj * HALF); } }
#pragma unroll
            for (int m = 0; m < 4; ++m)
#pragma unroll
                for (int bj = 0; bj < 2; ++bj) { const u32x4 a_ = ga[m][bj], b_ = gb[m][bj];
                    f32x4 r0, r1;
                    r0[0] = bflo(a_.x) * __builtin_amdgcn_rcpf(bflo(b_.x)); r0[1] = bfhi(a_.x) * __builtin_amdgcn_rcpf(bfhi(b_.x));
                    r0[2] = bflo(a_.y) * __builtin_amdgcn_rcpf(bflo(b_.y)); r0[3] = bfhi(a_.y) * __builtin_amdgcn_rcpf(bfhi(b_.y));
                    r1[0] = bflo(a_.z) * __builtin_amdgcn_rcpf(bflo(b_.z)); r1[1] = bfhi(a_.z) * __builtin_amdgcn_rcpf(bfhi(b_.z));
                    r1[2] = bflo(a_.w) * __builtin_amdgcn_rcpf(bflo(b_.w)); r1[3] = bfhi(a_.w) * __builtin_amdgcn_rcpf(bfhi(b_.w));
                    acc[ai][bj][m][0] = acc[ai][bj][m][0] * r0; acc[ai][bj][m][1] = acc[ai][bj][m][1] * r1; }
            asm volatile("" ::: "memory"); }
    }
    __device__ __forceinline__ void operator()(const f32x4 (&acc)[2][2][4][2], const Unit& u, int wr, int wc, int fr, int fq) const {
        int row0 = u.pm * BM + wr * 64 + fr, col0 = u.pn * BM + wc * 32 + 8 * fq; asm volatile("" : "+v"(row0), "+v"(col0));
#pragma unroll
        for (int ai = 0; ai < 2; ++ai) {
            u32x4 gc[4][2];
#pragma unroll
            for (int m = 0; m < 4; ++m) { const bf16_t* gp = P + (size_t)(row0 + ai * HALF + m * 16) * INW + OFF_MG + 2 * 2048 + col0;
#pragma unroll
                for (int bj = 0; bj < 2; ++bj) gc[m][bj] = *(const u32x4*)(gp + bj * HALF); }
#pragma unroll
            for (int m = 0; m < 4; ++m) { bf16_t* rowp = O + (size_t)(row0 + ai * HALF + m * 16) * LDX + col0;
#pragma unroll
                for (int bj = 0; bj < 2; ++bj) { const u32x4 g_ = gc[m][bj];
                    const f32x4 v0 = acc[ai][bj][m][0], v1 = acc[ai][bj][m][1];
                    u32x4 w; w.x = cvt_pk_bf16(v0[0] * bflo(g_.x), v0[1] * bfhi(g_.x)); w.y = cvt_pk_bf16(v0[2] * bflo(g_.y), v0[3] * bfhi(g_.y));
                    w.z = cvt_pk_bf16(v1[0] * bflo(g_.z), v1[1] * bfhi(g_.z)); w.w = cvt_pk_bf16(v1[2] * bflo(g_.w), v1[3] * bfhi(g_.w));
                    *(u32x4*)(rowp + bj * HALF) = w; } }
            asm volatile("" ::: "memory"); }
    }
};

struct EpiOut {
    static constexpr bool PERM = true, MIDK = false, ALIGN = true;
    const float* xold_f32; const bf16_t* xold_b16; bf16_t* xnew_b16; const float* xold_ctx; float* xnew_ctx; const float* mod;
    __device__ __forceinline__ void mid(f32x4 (&)[2][2][4][2], const Unit&, int, int, int, int, int) const {}
    __device__ __forceinline__ void operator()(const f32x4 (&acc)[2][2][4][2], const Unit& u, int wr, int wc, int fr, int fq) const {
        const bool isctx = u.pm >= (MLAT / BM);
        const int mrow = isctx ? 4 : (u.pm >> 4);
        int row0 = u.pm * BM + wr * 64 + fr, col0 = u.pn * BM + wc * 32 + 8 * fq; asm volatile("" : "+v"(row0), "+v"(col0));
        f32x4 gv[2][2];
#pragma unroll
        for (int bj = 0; bj < 2; ++bj)
#pragma unroll
            for (int n = 0; n < 2; ++n) gv[bj][n] = *(const f32x4*)(mod + mrow * 6144 + 4096 + col0 + bj * HALF + n * 4);
        if (isctx) {
            const float* xo = xold_ctx - (size_t)MLAT * D; float* xn = xnew_ctx - (size_t)MLAT * D;
#pragma unroll
            for (int am = 0; am < 4; ++am) {
                const int ai = am >> 1, mb = (am & 1) * 2;
                f32x4 xv[2][2][2];
#pragma unroll
                for (int mm = 0; mm < 2; ++mm) { const size_t off = (size_t)(row0 + ai * HALF + (mb + mm) * 16) * D + col0;
#pragma unroll
                    for (int bj = 0; bj < 2; ++bj)
#pragma unroll
                        for (int n = 0; n < 2; ++n) xv[mm][bj][n] = *(const f32x4*)(xo + off + bj * HALF + n * 4); }
#pragma unroll
                for (int mm = 0; mm < 2; ++mm) { const size_t off = (size_t)(row0 + ai * HALF + (mb + mm) * 16) * D + col0;
#pragma unroll
                    for (int bj = 0; bj < 2; ++bj)
#pragma unroll
                        for (int n = 0; n < 2; ++n) *(f32x4*)(xn + off + bj * HALF + n * 4) = xv[mm][bj][n] + gv[bj][n] * acc[ai][bj][mb + mm][n]; }
                asm volatile("" ::: "memory"); }
        } else if (xold_b16) {
#pragma unroll
            for (int ai = 0; ai < 2; ++ai) {
                u32x4 xb[4][2];
#pragma unroll
                for (int m = 0; m < 4; ++m) { const size_t off = (size_t)(row0 + ai * HALF + m * 16) * D + col0;
#pragma unroll
                    for (int bj = 0; bj < 2; ++bj) xb[m][bj] = *(const u32x4*)(xold_b16 + off + bj * HALF); }
#pragma unroll
                for (int m = 0; m < 4; ++m) { const size_t off = (size_t)(row0 + ai * HALF + m * 16) * D + col0;
#pragma unroll
                    for (int bj = 0; bj < 2; ++bj) { const u32x4 x_ = xb[m][bj]; const f32x4 a0 = acc[ai][bj][m][0], a1 = acc[ai][bj][m][1], g0 = gv[bj][0], g1 = gv[bj][1];
                        u32x4 w; w.x = cvt_pk_bf16(bflo(x_.x) + g0[0] * a0[0], bfhi(x_.x) + g0[1] * a0[1]); w.y = cvt_pk_bf16(bflo(x_.y) + g0[2] * a0[2], bfhi(x_.y) + g0[3] * a0[3]);
                        w.z = cvt_pk_bf16(bflo(x_.z) + g1[0] * a1[0], bfhi(x_.z) + g1[1] * a1[1]); w.w = cvt_pk_bf16(bflo(x_.w) + g1[2] * a1[2], bfhi(x_.w) + g1[3] * a1[3]);
                        *(u32x4*)(xnew_b16 + off + bj * HALF) = w; } }
                asm volatile("" ::: "memory"); }
        } else {
#pragma unroll
            for (int am = 0; am < 4; ++am) {
                const int ai = am >> 1, mb = (am & 1) * 2;
                f32x4 xv[2][2][2];
#pragma unroll
                for (int mm = 0; mm < 2; ++mm) { const size_t off = (size_t)(row0 + ai * HALF + (mb + mm) * 16) * D + col0;
#pragma unroll
                    for (int bj = 0; bj < 2; ++bj)
#pragma unroll
                        for (int n = 0; n < 2; ++n) xv[mm][bj][n] = *(const f32x4*)(xold_f32 + off + bj * HALF + n * 4); }
#pragma unroll
                for (int mm = 0; mm < 2; ++mm) { const size_t off = (size_t)(row0 + ai * HALF + (mb + mm) * 16) * D + col0;
#pragma unroll
                    for (int bj = 0; bj < 2; ++bj) { const f32x4 v0 = xv[mm][bj][0] + gv[bj][0] * acc[ai][bj][mb + mm][0], v1 = xv[mm][bj][1] + gv[bj][1] * acc[ai][bj][mb + mm][1];
                        u32x4 w; w.x = cvt_pk_bf16(v0[0], v0[1]); w.y = cvt_pk_bf16(v0[2], v0[3]); w.z = cvt_pk_bf16(v1[0], v1[1]); w.w = cvt_pk_bf16(v1[2], v1[3]);
                        *(u32x4*)(xnew_b16 + off + bj * HALF) = w; } }
                asm volatile("" ::: "memory"); }
        }
    }
};
}

struct Args {
    const float* x; const float* c; const float* ctx; const float* c_ctx; const float* w_ada; const float* b_ada; const float* norm_g; const float* w_in;
    const float* w_fourier; const float* w_pool; const float* pool_scale; const float* decay_logit; const float* w_up_f; const float* w_up_p; const float* w_up_r;
    const float* w_out; const float* final_g; float* out; unsigned char* ws;
    int ph_lo, ph_hi;
};

struct Frame {
    LAS unsigned char* lds; int tid, lane, wave, G, bid;
};

__device__ __forceinline__ void transpose_item(const float* W, int N, bf16_t* WT, int ldo, int koff, LAS float* scr, int item, int lane) {
    const int nblk = N / 64, kb = item / nblk, nb = item % nblk, k0 = 64 * kb, n0 = 64 * nb;
    float wv[64];
#pragma unroll
    for (int i = 0; i < 64; ++i) wv[i] = W[(size_t)(k0 + i) * N + n0 + lane];
#pragma unroll
    for (int i = 0; i < 64; ++i) scr[i * 65 + lane] = wv[i];
    LDS_WAIT();
    const int c = lane & 7;
#pragma unroll
    for (int j = 0; j < 8; ++j) { const int n = (lane >> 3) + 8 * j; const LAS float* s_ = scr + (8 * c) * 65 + n;
        u32x4 o; o.x = pk2(s_[0 * 65], s_[1 * 65]); o.y = pk2(s_[2 * 65], s_[3 * 65]); o.z = pk2(s_[4 * 65], s_[5 * 65]); o.w = pk2(s_[6 * 65], s_[7 * 65]);
        *(u32x4*)(WT + (size_t)(n0 + n) * ldo + koff + k0 + 8 * c) = o; }
    LDS_WAIT();
}

__device__ __forceinline__ void weights_layer(const Args& a, const Frame& F, int l, int parts, int widx, int nwk) {
    LAS float* scr = (LAS float*)(F.lds + F.wave * 16640);
    const int gw = widx * 8 + F.wave, NGW = nwk * 8;
    bf16_t* WIN = (bf16_t*)(a.ws + WS_WIN); bf16_t* WUP = (bf16_t*)(a.ws + WS_WUP); bf16_t* WOUT = (bf16_t*)(a.ws + WS_WOUT);
    constexpr int I_IN = 32 * 192, I_UF = 8 * 32, I_UP = 8 * 32, I_UR = 16 * 32, I_O = 32 * 32;
    if (parts & 1) for (int it = gw; it < I_IN / 2; it += NGW) transpose_item(a.w_in + (size_t)l * D * INW, INW, WIN, LDX, 0, scr, it, F.lane);
    if (parts & 16) for (int it = I_IN / 2 + gw; it < I_IN; it += NGW) transpose_item(a.w_in + (size_t)l * D * INW, INW, WIN, LDX, 0, scr, it, F.lane);
    if (parts & 2) for (int it = gw; it < I_UF + I_UP + I_UR; it += NGW) {
        int r = it;
        if (r < I_UF) { transpose_item(a.w_up_f + (size_t)l * 512 * D, D, WUP, LDX, 0, scr, r, F.lane); continue; } r -= I_UF;
        if (r < I_UP) { transpose_item(a.w_up_p + (size_t)l * 512 * D, D, WUP, LDX, 512, scr, r, F.lane); continue; } r -= I_UP;
        transpose_item(a.w_up_r + (size_t)l * 1024 * D, D, WUP, LDX, 1024, scr, r, F.lane);
    }
    if (parts & 4) for (int it = gw; it < I_O; it += NGW) transpose_item(a.w_out + (size_t)l * D * D, D, WOUT, LDX, 0, scr, it, F.lane);
    if (parts & 8) {
        const int gt = widx * 512 + F.tid, NT = nwk * 512;
        bf16_t* WCST = (bf16_t*)(a.ws + WS_WCST); bf16_t* WPT = (bf16_t*)(a.ws + WS_WPT);
        const float* wf = a.w_fourier + (size_t)l * 4 * 128 * 128; const float* wp = a.w_pool + (size_t)l * 4 * 128 * 128;
        for (int o = gt; o < 4 * 8 * 128 * 32; o += NT) {
            const int jj = o & 7, fq = (o >> 3) & 3, d = (o >> 5) & 127, cbk = (o >> 12) & 7, g = o >> 15;
            const int cch = cbk * 16 + fq * 4 + (jj & 3); const bool is_sin = jj >= 4;
            float s = 0.f;
            for (int dp = 0; dp < 128; ++dp) { const float rev = (float)((cch * dp) & 127) * (1.0f / 128.0f);
                const float tw = is_sin ? sin_rev(rev) : cos_rev(rev); s += tw * wf[(g * 128 + dp) * 128 + d]; }
            WCST[o] = (bf16_t)f2bf(s * 0.08838834764831845f);
        }
        for (int o = gt; o < 4 * 128 * 128; o += NT) { const int cch = o & 127, d = (o >> 7) & 127, g = o >> 14; WPT[o] = (bf16_t)f2bf(wp[(g * 128 + cch) * 128 + d]); }
    }
}

__device__ __forceinline__ void p0_misc(const Args& a, const Frame& F) {
    const int gt = F.bid * 512 + F.tid, NT = F.G * 512;
    bf16_t* A1 = (bf16_t*)(a.ws + WS_A1); bf16_t* A3 = (bf16_t*)(a.ws + WS_A3); float* LG = (float*)(a.ws + WS_LG);
    for (int o = gt; o < 128 * 64; o += NT) { const int aa = o & 63, r = o >> 6, m1 = r & 63; const float rev = (float)((m1 * aa) & 63) * (1.0f / 64.0f);
        A1[o] = (bf16_t)f2bf(r < 64 ? cos_rev(rev) : -sin_rev(rev)); }
    for (int o = gt; o < 128 * 128; o += NT) { const int k = o & 127, r = o >> 7, m2 = r & 63, n2 = k >> 1, ri = k & 1; const float rev = (float)((m2 * n2) & 63) * (1.0f / 64.0f);
        const float cs = cos_rev(rev), sn = sin_rev(rev);
        const float v = (r < 64) ? (ri == 0 ? cs : sn) : (ri == 0 ? -sn : cs);
        A3[o] = (bf16_t)f2bf(v); }
    for (int o = gt; o < 32; o += NT) { const float z = a.decay_logit[o]; LG[o] = -log1pf(expf(-z)); }
}

__device__ __forceinline__ void p0_mod(const Args& a, const Frame& F) {
    LAS float* sc = (LAS float*)F.lds;
    LAS float* red = (LAS float*)(F.lds + 5 * 2048 * 4);
    float* MOD = (float*)(a.ws + WS_MOD);
    bool have = false;
    for (int it = F.bid; it < 2 * 96; it += F.G) {
        if (!have) {
            for (int o = F.tid; o < 5 * 2048; o += 512) { const float v = (o < 4 * 2048) ? a.c[o] : a.c_ctx[o - 4 * 2048]; sc[o] = v * sigmoidf_(v); }
            have = true;
        }
        __syncthreads();
        const int l = it / 96, cg0 = (it % 96) * 64;
        const int cq = F.tid & 15, ks = F.tid >> 4;
        const float* W = a.w_ada + (size_t)l * D * 6144 + cg0 + cq * 4;
        f32x4 ac[5];
#pragma unroll
        for (int r = 0; r < 5; ++r) ac[r] = (f32x4){0.f, 0.f, 0.f, 0.f};
#pragma unroll 16
        for (int kk = 0; kk < 64; ++kk) { const int k = ks * 64 + kk; const f32x4 w = *(const f32x4*)(W + (size_t)k * 6144);
#pragma unroll
            for (int r = 0; r < 5; ++r) ac[r] += w * sc[r * 2048 + k]; }
#pragma unroll
        for (int r = 0; r < 5; ++r)
#pragma unroll
            for (int j = 0; j < 4; ++j) red[(ks * 16 + cq) * 20 + r * 4 + j] = ac[r][j];
        __syncthreads();
        if (F.tid < 320) { const int cq2 = F.tid / 20, rj = F.tid % 20, r = rj >> 2, j = rj & 3; float s = 0.f;
            for (int k2 = 0; k2 < 32; ++k2) s += red[(k2 * 16 + cq2) * 20 + rj];
            const int col = cg0 + cq2 * 4 + j;
            MOD[(l * 5 + r) * 6144 + col] = s + a.b_ada[l * 6144 + col]; }
        __syncthreads();
    }
}

__device__ __forceinline__ void prenorm_b16(const Args& a, const Frame& F, int l) {
    const int gw = F.bid * 8 + F.wave, NGW = F.G * 8;
    const float* MOD = (const float*)(a.ws + WS_MOD) + (size_t)l * 5 * 6144;
    const bf16_t* xb = (const bf16_t*)a.out; const float* ng = a.norm_g + (size_t)l * D;
    bf16_t* XN = (bf16_t*)(a.ws + WS_XN);
    u32x4 nx[4];
    if (gw < MLAT) {
#pragma unroll
        for (int j = 0; j < 4; ++j) nx[j] = *(const u32x4*)(xb + (size_t)gw * D + (j * 64 + F.lane) * 8); }
    for (int m = gw; m < MLAT; m += NGW) {
        const int mrow = m >> 12;
        float v[4][8]; float s = 0.f;
#pragma unroll
        for (int j = 0; j < 4; ++j) { unpack8(nx[j], v[j]);
#pragma unroll
            for (int e = 0; e < 8; ++e) s += v[j][e] * v[j][e]; }
        const int m2 = m + NGW;
        if (m2 < MLAT) {
#pragma unroll
            for (int j = 0; j < 4; ++j) nx[j] = *(const u32x4*)(xb + (size_t)m2 * D + (j * 64 + F.lane) * 8); }
#pragma unroll
        for (int o = 1; o < 64; o <<= 1) s += __shfl_xor(s, o);
        const float r = 1.0f / sqrtf(s * (1.0f / D) + EPS);
#pragma unroll
        for (int j = 0; j < 4; ++j) { const int col = (j * 64 + F.lane) * 8; float h[8];
#pragma unroll
            for (int hh = 0; hh < 2; ++hh) { const f32x4 g = *(const f32x4*)(ng + col + 4 * hh), sh = *(const f32x4*)(MOD + mrow * 6144 + col + 4 * hh), sc = *(const f32x4*)(MOD + mrow * 6144 + 2048 + col + 4 * hh);
#pragma unroll
                for (int e = 0; e < 4; ++e) h[4 * hh + e] = (v[j][4 * hh + e] * r) * g[e] * (sc[e] + 1.0f) + sh[e]; }
            *(u32x4*)(XN + (size_t)m * LDX + col) = pack8(h); }
    }
}
__device__ __forceinline__ void prenorm(const Args& a, const Frame& F, int l, int m_lo) {
    const int gw = m_lo + F.bid * 8 + F.wave, NGW = F.G * 8;
    const float* MOD = (const float*)(a.ws + WS_MOD) + (size_t)l * 5 * 6144;
    const float* xl = (l == 0) ? a.x : a.out; const float* xc = (l == 0) ? a.ctx : (const float*)(a.ws + WS_CTX1);
    const float* ng = a.norm_g + (size_t)l * D;
    bf16_t* XN = (bf16_t*)(a.ws + WS_XN);
    f32x4 v[8], nx[8];
    if (gw < MTOT) { const f32x4* xr = (const f32x4*)(gw >= MLAT ? xc + (size_t)(gw - MLAT) * D : xl + (size_t)gw * D) + F.lane;
#pragma unroll
        for (int j = 0; j < 8; ++j) nx[j] = xr[64 * j]; }
    for (int m = gw; m < MTOT; m += NGW) {
        const bool isctx = m >= MLAT; const int mrow = isctx ? 4 : (m >> 12);
#pragma unroll
        for (int j = 0; j < 8; ++j) v[j] = nx[j];
        const int m2 = m + NGW;
        if (m2 < MTOT) { const f32x4* xr = (const f32x4*)(m2 >= MLAT ? xc + (size_t)(m2 - MLAT) * D : xl + (size_t)m2 * D) + F.lane;
#pragma unroll
            for (int j = 0; j < 8; ++j) nx[j] = xr[64 * j]; }
        float s = 0.f;
#pragma unroll
        for (int j = 0; j < 8; ++j) s += (v[j].x * v[j].x + v[j].y * v[j].y) + (v[j].z * v[j].z + v[j].w * v[j].w);
#pragma unroll
        for (int o = 1; o < 64; o <<= 1) s += __shfl_xor(s, o);
        const float r = 1.0f / sqrtf(s * (1.0f / D) + EPS);
        const f32x4* gp = (const f32x4*)ng + F.lane; const f32x4* shp = (const f32x4*)(MOD + mrow * 6144) + F.lane; const f32x4* scp = (const f32x4*)(MOD + mrow * 6144 + 2048) + F.lane;
        u32x2* o8 = (u32x2*)(XN + (size_t)m * LDX) + F.lane;
#pragma unroll
        for (int j = 0; j < 8; ++j) { const f32x4 g = gp[64 * j], sh = shp[64 * j], sc = scp[64 * j];
            const f32x4 h = (v[j] * r) * g * (sc + 1.0f) + sh;
            u32x2 w; w.x = pk2(h.x, h.y); w.y = pk2(h.z, h.w); o8[64 * j] = w; }
    }
}

constexpr int LDP = 136;
__device__ __forceinline__ void chunk_decode(int it, int& b, int& h, int& cc, int& rowbase, bool& is_lat, int& posbase) {
    const int bh = it / NCH; cc = it % NCH; b = bh >> 3; h = bh & 7;
    if (cc < NCH_C) { is_lat = false; rowbase = MLAT + b * CTXL + cc * CH; posbase = cc * CH; }
    else { is_lat = true; rowbase = b * SEQ + (cc - NCH_C) * CH; posbase = (cc - NCH_C) * CH; }
}
__device__ __forceinline__ void load_vt(const bf16_t* proj, int rowbase, int h, LAS bf16_t* VT, int tid) {
#pragma unroll
    for (int q = 0; q < 4; ++q) { const int u = tid + q * 512, j = u & 127, e8 = (u >> 7) * 8;
        const u32x4 v = *(const u32x4*)(proj + (size_t)(rowbase + j) * INW + OFF_V + h * DK + e8);
        LAS bf16_t* p = VT + e8 * LDP + j;
        p[0 * LDP] = (bf16_t)(v.x & 0xffff); p[1 * LDP] = (bf16_t)(v.x >> 16); p[2 * LDP] = (bf16_t)(v.y & 0xffff); p[3 * LDP] = (bf16_t)(v.y >> 16);
        p[4 * LDP] = (bf16_t)(v.z & 0xffff); p[5 * LDP] = (bf16_t)(v.z >> 16); p[6 * LDP] = (bf16_t)(v.w & 0xffff); p[7 * LDP] = (bf16_t)(v.w >> 16); }
}

__device__ __forceinline__ void kv_phase(const Args& a, const Frame& F, int l, bool norope = false) {
    bf16_t* proj = (bf16_t*)(a.ws + WS_PROJ); bf16_t* KVT = (bf16_t*)(a.ws + WS_KVT); const float* LG = (const float*)(a.ws + WS_LG) + l * 16;
    LAS bf16_t* KFT = (LAS bf16_t*)F.lds; LAS bf16_t* KBT = KFT + 128 * LDP; LAS bf16_t* VT = KBT + 128 * LDP;
    const int fr = F.lane & 15, fq = F.lane >> 4;
    for (int it = F.bid; it < 32 * NCH; it += F.G) {
        int b, h, cc, rowbase, posbase; bool is_lat; chunk_decode(it, b, h, cc, rowbase, is_lat, posbase);
        if (norope) is_lat = false;
        const float lgf = LG[h], lgb = LG[8 + h];
        u32x4 kx1[2], kx2[2], qx1[2], qx2[2], vreg[4];
#pragma unroll
        for (int q = 0; q < 2; ++q) { const int u = F.tid + q * 512, j = u & 127, sub = u >> 7, base = (sub >> 2) * 64, i0 = (sub & 3) * 8;
            const bf16_t* kp = proj + (size_t)(rowbase + j) * INW + OFF_K + h * DK + base + i0; kx1[q] = *(const u32x4*)kp; kx2[q] = *(const u32x4*)(kp + 32);
            if (is_lat) { const bf16_t* qp = proj + (size_t)(rowbase + j) * INW + OFF_Q + h * DK + base + i0; qx1[q] = *(const u32x4*)qp; qx2[q] = *(const u32x4*)(qp + 32); } }
#pragma unroll
        for (int q = 0; q < 4; ++q) { const int u = F.tid + q * 512, j = u & 127, e8 = (u >> 7) * 8; vreg[q] = *(const u32x4*)(proj + (size_t)(rowbase + j) * INW + OFF_V + h * DK + e8); }
#pragma unroll
        for (int q = 0; q < 2; ++q) {
            const int u = F.tid + q * 512, j = u & 127, sub = u >> 7, base = (sub >> 2) * 64, i0 = (sub & 3) * 8;
            const int n = posbase + j; const float pos = (float)(base == 0 ? (n >> 6) : (n & 63));
            float cs[8], sn[8];
#pragma unroll
            for (int e = 0; e < 8; ++e) { const float inv = exp2f(-(float)(i0 + e) * (13.287712379549449f / 32.0f)); float rev = pos * inv * 0.15915494309189535f; rev -= floorf(rev);
                cs[e] = is_lat ? cos_rev(rev) : 1.0f; sn[e] = is_lat ? sin_rev(rev) : 0.0f; }
            bf16_t* kp = proj + (size_t)(rowbase + j) * INW + OFF_K + h * DK + base + i0;
            float x1[8], x2[8], o1[8], o2[8];
            unpack8(kx1[q], x1); unpack8(kx2[q], x2);
#pragma unroll
            for (int e = 0; e < 8; ++e) { o1[e] = x1[e] * cs[e] - x2[e] * sn[e]; o2[e] = x1[e] * sn[e] + x2[e] * cs[e]; }
            if (is_lat) { *(u32x4*)kp = pack8(o1); *(u32x4*)(kp + 32) = pack8(o2); }
            const float wf = __expf(lgf * (float)(CH - 1 - j)), wb = __expf(lgb * (float)j);
#pragma unroll
            for (int e = 0; e < 8; ++e) {
                KFT[(base + i0 + e) * LDP + j] = (bf16_t)f2bf(o1[e] * wf); KFT[(base + 32 + i0 + e) * LDP + j] = (bf16_t)f2bf(o2[e] * wf);
                KBT[(base + i0 + e) * LDP + j] = (bf16_t)f2bf(o1[e] * wb); KBT[(base + 32 + i0 + e) * LDP + j] = (bf16_t)f2bf(o2[e] * wb); }
            if (is_lat) {
                bf16_t* qp = proj + (size_t)(rowbase + j) * INW + OFF_Q + h * DK + base + i0;
                unpack8(qx1[q], x1); unpack8(qx2[q], x2);
#pragma unroll
                for (int e = 0; e < 8; ++e) { o1[e] = x1[e] * cs[e] - x2[e] * sn[e]; o2[e] = x1[e] * sn[e] + x2[e] * cs[e]; }
                *(u32x4*)qp = pack8(o1); *(u32x4*)(qp + 32) = pack8(o2);
            }
        }
#pragma unroll
        for (int q = 0; q < 4; ++q) { const int u = F.tid + q * 512, j = u & 127, e8 = (u >> 7) * 8; const u32x4 v = vreg[q];
            LAS bf16_t* p = VT + e8 * LDP + j;
            p[0 * LDP] = (bf16_t)(v.x & 0xffff); p[1 * LDP] = (bf16_t)(v.x >> 16); p[2 * LDP] = (bf16_t)(v.y & 0xffff); p[3 * LDP] = (bf16_t)(v.y >> 16);
            p[4 * LDP] = (bf16_t)(v.z & 0xffff); p[5 * LDP] = (bf16_t)(v.z >> 16); p[6 * LDP] = (bf16_t)(v.w & 0xffff); p[7 * LDP] = (bf16_t)(v.w >> 16); }
        __syncthreads();
        const int dt = F.wave;
#pragma unroll
        for (int dir = 0; dir < 2; ++dir) {
            const LAS bf16_t* T = dir ? KBT : KFT;
            bf16x8 af[4];
#pragma unroll
            for (int ks = 0; ks < 4; ++ks) af[ks] = *(const LAS bf16x8*)(T + (dt * 16 + fr) * LDP + ks * 32 + fq * 8);
            bf16_t* dst = KVT + ((size_t)it * 2 + dir) * 16384;
#pragma unroll
            for (int et = 0; et < 8; ++et) { f32x4 acc = (f32x4){0.f, 0.f, 0.f, 0.f};
#pragma unroll
                for (int ks = 0; ks < 4; ++ks) { const bf16x8 bv = *(const LAS bf16x8*)(VT + (et * 16 + fr) * LDP + ks * 32 + fq * 8); acc = mfma16(af[ks], bv, acc); }
                u32x2 w; w.x = pk2(acc[0], acc[1]); w.y = pk2(acc[2], acc[3]);
                *(u32x2*)(dst + (et * 16 + fr) * 128 + dt * 16 + fq * 4) = w; }
        }
        __syncthreads();
    }
}

__device__ __forceinline__ void fourier1(const Args& a, const Frame& F, int l) {
    const bf16_t* proj = (const bf16_t*)(a.ws + WS_PROJ); const bf16_t* A1 = (const bf16_t*)(a.ws + WS_A1); bf16_t* TP = (bf16_t*)(a.ws + WS_TP);
    const int fr = F.lane & 15, fq = F.lane >> 4, w = F.wave;
    LAS bf16_t* XS = (LAS bf16_t*)F.lds;
    {
        bf16x8 af[8][2];
#pragma unroll
        for (int t = 0; t < 8; ++t)
#pragma unroll
            for (int ks = 0; ks < 2; ++ks) af[t][ks] = *(const bf16x8*)(A1 + (t * 16 + fr) * 64 + ks * 32 + fq * 8);
        for (int it = F.bid; it < 256; it += F.G) {
            const int cblk = it & 15, nb = (it >> 4) & 3, b = it >> 6;
            u32x4 xr[8];
#pragma unroll
            for (int q = 0; q < 8; ++q) { const int u = F.tid + q * 512, row = u >> 2, ch = u & 3, aa = row >> 4, n2l = row & 15;
                xr[q] = *(const u32x4*)(proj + (size_t)(b * SEQ + 64 * aa + nb * 16 + n2l) * INW + OFF_FX + cblk * 32 + ch * 8); }
#pragma unroll
            for (int q = 0; q < 8; ++q) { const int u = F.tid + q * 512, row = u >> 2, ch = u & 3; *(LAS u32x4*)(XS + row * 40 + ch * 8) = xr[q]; }
            __syncthreads();
            const int n2 = nb * 16 + fr;
            float tcs[4][4], tsn[4][4];
#pragma unroll
            for (int t = 0; t < 4; ++t)
#pragma unroll
                for (int r = 0; r < 4; ++r) { const int m1 = t * 16 + fq * 4 + r; const float rev = (float)((m1 * n2) & 4095) * (1.0f / 4096.0f); tcs[t][r] = cos_rev(rev) * (1.0f / 64.0f); tsn[t][r] = sin_rev(rev) * (1.0f / 64.0f); }
#pragma unroll 1
            for (int cl = 0; cl < 4; ++cl) {
                const int c = w * 4 + cl;
                bf16x8 bfrag[2];
#pragma unroll
                for (int ks = 0; ks < 2; ++ks)
#pragma unroll
                    for (int jj = 0; jj < 8; ++jj) bfrag[ks][jj] = (short)XS[((ks * 32 + fq * 8 + jj) * 16 + fr) * 40 + c];
                f32x4 acc[8];
#pragma unroll
                for (int t = 0; t < 8; ++t) { acc[t] = (f32x4){0.f, 0.f, 0.f, 0.f};
#pragma unroll
                    for (int ks = 0; ks < 2; ++ks) acc[t] = mfma16(af[t][ks], bfrag[ks], acc[t]); }
                const int cg_ = cblk * 32 + c;
#pragma unroll
                for (int t = 0; t < 4; ++t)
#pragma unroll
                    for (int r = 0; r < 4; ++r) { const int m1 = t * 16 + fq * 4 + r; const float tr = acc[t][r], ti = acc[t + 4][r];
                        *(unsigned*)(TP + ((size_t)(b * 64 + m1) * 512 + cg_) * 128 + 2 * n2) = pk2(tr * tcs[t][r] + ti * tsn[t][r], ti * tcs[t][r] - tr * tsn[t][r]); }
            }
            __syncthreads();
        }
    }
    if (l == 0) {
        const int gt = F.bid * 512 + F.tid, NT = F.G * 512;
        for (int o = gt; o < 4 * 4 * 64 * 512; o += NT) {
            const int c = o & 511, n2 = (o >> 9) & 63, m1 = (o >> 15) & 3, b = o >> 17;
            float tr = 0.f, ti = 0.f;
#pragma unroll
            for (int aa = 0; aa < 4; ++aa) { const float x = bf2f(proj[(size_t)(MLAT + b * CTXL + 64 * aa + n2) * INW + OFF_FX + c]); const float rev = (float)((m1 * aa) & 3) * 0.25f;
                tr += x * cos_rev(rev); ti -= x * sin_rev(rev); }
            const float rev = (float)((m1 * n2) & 255) * (1.0f / 256.0f); const float cs = cos_rev(rev), sn = sin_rev(rev);
            const float tr2 = (tr * cs + ti * sn) * (1.0f / 16.0f), ti2 = (ti * cs - tr * sn) * (1.0f / 16.0f);
            *(unsigned*)(TP + TP_CTX_OFF + ((size_t)(b * 4 + m1) * 512 + c) * 128 + 2 * n2) = pk2(tr2, ti2);
        }
    }
}

template <int G>
__device__ __forceinline__ void pool_item(const bf16_t* proj, const LAS bf16_t* WPL, const LAS bf16_t* ROWS, bf16_t* AB, const float* psc, int row0, int t, int N, int tl, int fr, int fq) {
    constexpr int half = 1 << G;
    const int lo = max(t - half, 0), hi = min(t + half, N); const float rc = 1.0f / (float)(hi - lo);
    bf16x8 af[4];
#pragma unroll
    for (int ks = 0; ks < 4; ++ks) {
        const LAS bf16_t* cp = ROWS + (tl - half) * LDP + ks * 32 + fq * 8;
        float s[8], me[8], f[8];
#pragma unroll
        for (int e = 0; e < 8; ++e) s[e] = 0.f;
#pragma unroll
        for (int dd = 0; dd < 2 * half; ++dd) { unpack8(*(const LAS u32x4*)(cp + dd * LDP), f);
#pragma unroll
            for (int e = 0; e < 8; ++e) s[e] += f[e]; }
        unpack8(*(const LAS u32x4*)(cp + half * LDP), me);
#pragma unroll
        for (int e = 0; e < 8; ++e) s[e] = s[e] * rc - me[e];
        af[ks] = as_bf16x8(pack8(s));
    }
    const size_t row = (size_t)(row0 + fr);
#pragma unroll
    for (int dt = 0; dt < 8; ++dt) { f32x4 acc = (f32x4){0.f, 0.f, 0.f, 0.f};
#pragma unroll
        for (int ks = 0; ks < 4; ++ks) { const bf16x8 wv = *(const LAS bf16x8*)(WPL + (dt * 16 + fr) * LDP + ks * 32 + fq * 8); acc = mfma16(wv, af[ks], acc); }
        const int d0 = G * 128 + dt * 16 + fq * 4; const f32x4 ps = *(const f32x4*)(psc + d0); const u32x2 gv = *(const u32x2*)(proj + row * INW + OFF_PG + d0);
        u32x2 o; o.x = pk2(acc[0] * ps[0] * bflo(gv.x), acc[1] * ps[1] * bfhi(gv.x)); o.y = pk2(acc[2] * ps[2] * bflo(gv.y), acc[3] * ps[3] * bfhi(gv.y));
        *(u32x2*)(AB + row * LDX + 512 + d0) = o;
        if (dt & 1) asm volatile("" ::: "memory"); }
}
__device__ __forceinline__ void pool_phase(const Args& a, const Frame& F, int l) {
    const bf16_t* proj = (const bf16_t*)(a.ws + WS_PROJ); const bf16_t* WPT = (const bf16_t*)(a.ws + WS_WPT); bf16_t* AB = (bf16_t*)(a.ws + WS_XN);
    const float* psc = a.pool_scale + (size_t)l * 512;
    const int NGW = F.G * 8, fr = F.lane & 15, fq = F.lane >> 4;
    const int ntb = (l == 0 ? MTOT : MLAT) / 16, nitems = 4 * ntb;
    LAS bf16_t* WPL = (LAS bf16_t*)F.lds;
    LAS bf16_t* ROWS = WPL + 128 * LDP;
    int cur_g = -1;
    for (int it0 = F.bid * 8; it0 < nitems; it0 += NGW) {
        const int g = it0 / ntb, tb0 = it0 - g * ntb, row0b = tb0 * 16;
        int seqbase, N;
        if (row0b < MLAT) { seqbase = row0b & ~(SEQ - 1); N = SEQ; } else { seqbase = MLAT + ((row0b - MLAT) & ~(CTXL - 1)); N = CTXL; }
        const int T0 = row0b - seqbase;
        __syncthreads();
        if (g != cur_g) {
            for (int o = F.tid; o < 128 * 16; o += 512) { const int r = o >> 4, c16 = o & 15; *(LAS u32x4*)(WPL + r * LDP + c16 * 8) = *(const u32x4*)(WPT + (size_t)(g * 128 + r) * 128 + c16 * 8); }
            cur_g = g;
        }
        {
            u32x4 rv[5];
#pragma unroll
            for (int k = 0; k < 5; ++k) { const int u = F.tid + k * 512, r = u >> 4, c16 = u & 15, tt = T0 - 8 + r;
                rv[k] = (u < 144 * 16 && tt >= 0 && tt < N) ? *(const u32x4*)(proj + (size_t)(seqbase + tt) * INW + OFF_PX + g * 128 + c16 * 8) : (u32x4){0u, 0u, 0u, 0u}; }
#pragma unroll
            for (int k = 0; k < 5; ++k) { const int u = F.tid + k * 512, r = u >> 4, c16 = u & 15; if (u < 144 * 16) *(LAS u32x4*)(ROWS + r * LDP + c16 * 8) = rv[k]; }
        }
        __syncthreads();
        const int it = it0 + F.wave;
        if (it >= nitems) continue;
        const int row0 = row0b + F.wave * 16, t = T0 + F.wave * 16 + fr, tl = 8 + F.wave * 16 + fr;
        if (g == 0) pool_item<0>(proj, WPL, ROWS, AB, psc, row0, t, N, tl, fr, fq);
        else if (g == 1) pool_item<1>(proj, WPL, ROWS, AB, psc, row0, t, N, tl, fr, fq);
        else if (g == 2) pool_item<2>(proj, WPL, ROWS, AB, psc, row0, t, N, tl, fr, fq);
        else pool_item<3>(proj, WPL, ROWS, AB, psc, row0, t, N, tl, fr, fq);
    }
    __syncthreads();
}

__device__ __forceinline__ void scan_phase(const Args& a, const Frame& F, int l) {
    const bf16_t* KVT = (const bf16_t*)(a.ws + WS_KVT); bf16_t* SST = (bf16_t*)(a.ws + WS_SST); const float* LG = (const float*)(a.ws + WS_LG) + l * 16;
    const int gt = F.bid * 512 + F.tid, NT = F.G * 512;
    for (int o = gt; o < 32 * 2 * 128 * 16; o += NT) {
        const int d8 = o & 15, e = (o >> 4) & 127, dir = (o >> 11) & 1, bh = o >> 12, h = bh & 7;
        const float dec = __expf(LG[dir * 8 + h] * (float)CH);
        float s[8];
#pragma unroll
        for (int q = 0; q < 8; ++q) s[q] = 0.f;
        for (int st0 = 0; st0 < NCH; st0 += 17) {
            u32x4 kvr[17]; size_t offs[17];
#pragma unroll
            for (int q = 0; q < 17; ++q) { const int st = st0 + q; const int cc = (dir == 0) ? st : ((st < NCH_C) ? (NCH_C - 1 - st) : (NCH - 1 - (st - NCH_C)));
                offs[q] = ((size_t)(bh * NCH + cc) * 2 + dir) * 16384 + e * 128 + d8 * 8; kvr[q] = *(const u32x4*)(KVT + offs[q]); }
#pragma unroll
            for (int q = 0; q < 17; ++q) { *(u32x4*)(SST + offs[q]) = pack8(s); float kv[8]; unpack8(kvr[q], kv);
#pragma unroll
                for (int z = 0; z < 8; ++z) s[z] = dec * s[z] + kv[z]; }
        }
    }
}

__device__ __forceinline__ void fourier2(const Args& a, const Frame& F, int l) {
    const bf16_t* proj = (const bf16_t*)(a.ws + WS_PROJ); const bf16_t* A3 = (const bf16_t*)(a.ws + WS_A3); const bf16_t* TP = (const bf16_t*)(a.ws + WS_TP);
    const bf16_t* WCST = (const bf16_t*)(a.ws + WS_WCST); bf16_t* AB = (bf16_t*)(a.ws + WS_XN);
    const int gw = F.bid * 8 + F.wave, NGW = F.G * 8, fr = F.lane & 15, fq = F.lane >> 4;
    const int nlat = 4 * 64 * 4 * 4, nitems = nlat + (l == 0 ? 4 * 4 * 4 * 4 : 0);
    LAS bf16_t* WCL = (LAS bf16_t*)F.lds;
    LAS bf16_t* TPL = (LAS bf16_t*)(F.lds + 65536);
    int cur_g = -1;
    for (int it0 = F.bid * 8; it0 < nitems; it0 += NGW) {
        const int it = it0 + F.wave;
        const int gblk = (it0 < nlat) ? ((it0 >> 8) & 3) : ((it0 - nlat) >> 6);
        __syncthreads();
        if (gblk != cur_g) {
            for (int o = F.tid; o < 4096; o += 512) *(LAS u32x4*)(WCL + o * 8) = *(const u32x4*)(WCST + (size_t)gblk * 32768 + (size_t)o * 8);
            cur_g = gblk;
        }
        {
            u32x4 tv[8];
#pragma unroll
            for (int k = 0; k < 8; ++k) { const int u = F.tid + k * 512, q = u >> 11, row = (u >> 4) & 127, c16 = u & 15; const int itq = it0 + 4 * q;
                const bf16_t* tq;
                if (itq < nlat) tq = TP + ((size_t)((itq >> 10) * 64 + ((itq >> 2) & 63)) * 512 + ((itq >> 8) & 3) * 128) * 128;
                else { const int i2 = itq - nlat; tq = TP + TP_CTX_OFF + ((size_t)(((i2 >> 4) & 3) * 4 + ((i2 >> 2) & 3)) * 512 + (i2 >> 6) * 128) * 128; }
                tv[k] = (itq < nitems) ? *(const u32x4*)(tq + (size_t)row * 128 + c16 * 8) : (u32x4){0u, 0u, 0u, 0u}; }
#pragma unroll
            for (int k = 0; k < 8; ++k) { const int u = F.tid + k * 512, q = u >> 11, row = (u >> 4) & 127, c16 = u & 15; *(LAS u32x4*)(TPL + (q * 128 + row) * LDP + c16 * 8) = tv[k]; }
        }
        __syncthreads();
        if (it >= nitems) continue;
        int mb, g, m1, s, NM1, seqbase;
        if (it < nlat) { mb = it & 3; m1 = (it >> 2) & 63; g = (it >> 8) & 3; s = it >> 10; NM1 = 64; seqbase = s * SEQ; }
        else { const int i2 = it - nlat; mb = i2 & 3; m1 = (i2 >> 2) & 3; s = (i2 >> 4) & 3; g = i2 >> 6; NM1 = 4; seqbase = MLAT + s * CTXL; }
        const LAS bf16_t* tpl = TPL + (F.wave >> 2) * 128 * LDP;
        f32x4 accY[8][2];
#pragma unroll
        for (int cbk = 0; cbk < 8; ++cbk) { accY[cbk][0] = (f32x4){0.f, 0.f, 0.f, 0.f}; accY[cbk][1] = (f32x4){0.f, 0.f, 0.f, 0.f}; }
#pragma unroll
        for (int ks = 0; ks < 4; ++ks) {
            const bf16x8 b0 = *(const bf16x8*)(A3 + (mb * 16 + fr) * 128 + ks * 32 + fq * 8), b1 = *(const bf16x8*)(A3 + (64 + mb * 16 + fr) * 128 + ks * 32 + fq * 8);
#pragma unroll
            for (int cbk = 0; cbk < 8; ++cbk) { const bf16x8 av = *(const LAS bf16x8*)(tpl + (cbk * 16 + fr) * LDP + ks * 32 + fq * 8);
                accY[cbk][0] = mfma16(av, b0, accY[cbk][0]); accY[cbk][1] = mfma16(av, b1, accY[cbk][1]); }
        }
        f32x4 acc2[8];
#pragma unroll
        for (int dt = 0; dt < 8; ++dt) acc2[dt] = (f32x4){0.f, 0.f, 0.f, 0.f};
#pragma unroll
        for (int cbk = 0; cbk < 8; ++cbk) {
            u32x4 w; w.x = pk2(accY[cbk][0][0], accY[cbk][0][1]); w.y = pk2(accY[cbk][0][2], accY[cbk][0][3]); w.z = pk2(accY[cbk][1][0], accY[cbk][1][1]); w.w = pk2(accY[cbk][1][2], accY[cbk][1][3]);
            const bf16x8 f2 = as_bf16x8(w);
#pragma unroll
            for (int dt = 0; dt < 8; ++dt) { const bf16x8 wv = *(const LAS bf16x8*)(WCL + ((cbk * 128 + dt * 16 + fr) * 4 + fq) * 8); acc2[dt] = mfma16(wv, f2, acc2[dt]); }
        }
        const size_t row = (size_t)(seqbase + m1 + NM1 * (mb * 16 + fr));
        u32x2 gv[8];
#pragma unroll
        for (int dt = 0; dt < 8; ++dt) gv[dt] = *(const u32x2*)(proj + row * INW + OFF_FG + g * 128 + dt * 16 + fq * 4);
#pragma unroll
        for (int dt = 0; dt < 8; ++dt) { u32x2 o; o.x = pk2(acc2[dt][0] * bflo(gv[dt].x), acc2[dt][1] * bfhi(gv[dt].x)); o.y = pk2(acc2[dt][2] * bflo(gv[dt].y), acc2[dt][3] * bfhi(gv[dt].y));
            *(u32x2*)(AB + row * LDX + g * 128 + dt * 16 + fq * 4) = o; }
        asm volatile("" ::: "memory");
    }
    __syncthreads();
}

__device__ __forceinline__ bf16x8 scale_frag(bf16x8 q, float s) {
    const u32x4 v = __builtin_bit_cast(u32x4, q); float f[8]; unpack8(v, f);
#pragma unroll
    for (int e = 0; e < 8; ++e) f[e] *= s;
    return as_bf16x8(pack8(f));
}
__device__ __forceinline__ void retout_phase(const Args& a, const Frame& F, int l, int mode, int skipwg) {
    const bf16_t* KVT = (const bf16_t*)(a.ws + WS_KVT);
    const bf16_t* proj = (const bf16_t*)(a.ws + WS_PROJ); const bf16_t* SST = (const bf16_t*)(a.ws + WS_SST); bf16_t* AB = (bf16_t*)(a.ws + WS_XN);
    const float* LG = (const float*)(a.ws + WS_LG) + l * 16;
    LAS bf16_t* KS = (LAS bf16_t*)F.lds; LAS bf16_t* VT = KS + 128 * LDP; LAS bf16_t* SF = VT + 128 * LDP; LAS bf16_t* SB = SF + 128 * LDP;
    const int fr = F.lane & 15, fq = F.lane >> 4, w = F.wave;
    const int widx = (mode == 2) ? F.bid - skipwg : F.bid, nwk = (mode == 2) ? F.G - skipwg : F.G, nv = (mode == 1) ? 32 * NCH_C : 32 * NCH_L;
    if (widx < 0) return;
    for (int v = widx; v < nv; v += nwk) {
        const int it = (mode == 1) ? ((v >> 1) * NCH + (v & 1)) : ((v >> 5) * NCH + NCH_C + (v & 31));
        int b, h, cc, rowbase, posbase; bool is_lat; chunk_decode(it, b, h, cc, rowbase, is_lat, posbase);
        const float lgf = LG[h], lgb = LG[8 + h];
        const int i = w * 16 + fr;
        {
            u32x4 kreg[4], sfreg[4], sbreg[4], vreg[4];
            const bf16_t* stf = SST + (size_t)it * 2 * 16384; const bf16_t* stb = stf + 16384; bool zf = false, zb = false;
            if (mode == 1) { stf = KVT + (size_t)(it - 1) * 2 * 16384; stb = KVT + (size_t)(it + 1) * 2 * 16384 + 16384; zf = (cc == 0); zb = (cc == 1); }
            const u32x4 zero4 = {0u, 0u, 0u, 0u};
#pragma unroll
            for (int q = 0; q < 4; ++q) { const int u = F.tid + q * 512, row = u >> 4, c16 = u & 15;
                kreg[q] = *(const u32x4*)(proj + (size_t)(rowbase + row) * INW + OFF_K + h * DK + c16 * 8);
                sfreg[q] = zf ? zero4 : *(const u32x4*)(stf + row * 128 + c16 * 8); sbreg[q] = zb ? zero4 : *(const u32x4*)(stb + row * 128 + c16 * 8); }
#pragma unroll
            for (int q = 0; q < 4; ++q) { const int u = F.tid + q * 512, j = u & 127, e8 = (u >> 7) * 8;
                vreg[q] = *(const u32x4*)(proj + (size_t)(rowbase + j) * INW + OFF_V + h * DK + e8); }
#pragma unroll
            for (int q = 0; q < 4; ++q) { const int u = F.tid + q * 512, row = u >> 4, c16 = u & 15;
                *(LAS u32x4*)(KS + row * LDP + c16 * 8) = kreg[q]; *(LAS u32x4*)(SF + row * LDP + c16 * 8) = sfreg[q]; *(LAS u32x4*)(SB + row * LDP + c16 * 8) = sbreg[q]; }
#pragma unroll
            for (int q = 0; q < 4; ++q) { const int u = F.tid + q * 512, j = u & 127, e8 = (u >> 7) * 8; const u32x4 v = vreg[q];
                LAS bf16_t* p = VT + e8 * LDP + j;
                p[0 * LDP] = (bf16_t)(v.x & 0xffff); p[1 * LDP] = (bf16_t)(v.x >> 16); p[2 * LDP] = (bf16_t)(v.y & 0xffff); p[3 * LDP] = (bf16_t)(v.y >> 16);
                p[4 * LDP] = (bf16_t)(v.z & 0xffff); p[5 * LDP] = (bf16_t)(v.z >> 16); p[6 * LDP] = (bf16_t)(v.w & 0xffff); p[7 * LDP] = (bf16_t)(v.w >> 16); }
        }
        bf16x8 qf[4];
#pragma unroll
        for (int ks = 0; ks < 4; ++ks) qf[ks] = *(const bf16x8*)(proj + (size_t)(rowbase + i) * INW + OFF_Q + h * DK + ks * 32 + fq * 8);
        __syncthreads();
        f32x4 accS[8];
#pragma unroll
        for (int jt = 0; jt < 8; ++jt) { accS[jt] = (f32x4){0.f, 0.f, 0.f, 0.f};
#pragma unroll
            for (int ks = 0; ks < 4; ++ks) { const bf16x8 kf = *(const LAS bf16x8*)(KS + (jt * 16 + fr) * LDP + ks * 32 + fq * 8); accS[jt] = mfma16(kf, qf[ks], accS[jt]); }
            if (jt & 1) asm volatile("" ::: "memory"); }
        const float l2f = lgf * 1.4426950408889634f, l2b = lgb * 1.4426950408889634f;
#pragma unroll
        for (int jt = 0; jt < 8; ++jt)
#pragma unroll
            for (int r = 0; r < 4; ++r) { const int j = jt * 16 + fq * 4 + r, dl = i - j;
                const float dv = dl > 0 ? exp2f((float)dl * l2f) : (dl < 0 ? exp2f((float)(-dl) * l2b) : 2.0f); accS[jt][r] *= dv; }
        f32x4 accO[8];
#pragma unroll
        for (int et = 0; et < 8; ++et) accO[et] = (f32x4){0.f, 0.f, 0.f, 0.f};
#pragma unroll
        for (int kb = 0; kb < 4; ++kb) {
            u32x4 pw; pw.x = pk2(accS[2 * kb][0], accS[2 * kb][1]); pw.y = pk2(accS[2 * kb][2], accS[2 * kb][3]); pw.z = pk2(accS[2 * kb + 1][0], accS[2 * kb + 1][1]); pw.w = pk2(accS[2 * kb + 1][2], accS[2 * kb + 1][3]);
            const bf16x8 pf = as_bf16x8(pw);
#pragma unroll
            for (int et = 0; et < 8; ++et) { const LAS bf16_t* vp = VT + (et * 16 + fr) * LDP + kb * 32 + fq * 4;
                const u32x2 lo = *(const LAS u32x2*)vp, hi = *(const LAS u32x2*)(vp + 16);
                u32x4 vv; vv.x = lo.x; vv.y = lo.y; vv.z = hi.x; vv.w = hi.y;
                accO[et] = mfma16(as_bf16x8(vv), pf, accO[et]); }
            asm volatile("" ::: "memory");
        }
        const float sf = __expf(lgf * (float)(i + 1)), sb = __expf(lgb * (float)(CH - i));
#pragma unroll
        for (int dir = 0; dir < 2; ++dir) {
            const LAS bf16_t* st = dir ? SB : SF;
#pragma unroll
            for (int ks = 0; ks < 4; ++ks) { const bf16x8 qs = scale_frag(qf[ks], dir ? sb : sf);
#pragma unroll
                for (int et = 0; et < 8; ++et) { const bf16x8 sv = *(const LAS bf16x8*)(st + (et * 16 + fr) * LDP + ks * 32 + fq * 8); accO[et] = mfma16(sv, qs, accO[et]); }
                asm volatile("" ::: "memory"); }
        }
        float ss = 0.f;
#pragma unroll
        for (int et = 0; et < 8; ++et) ss += (accO[et][0] * accO[et][0] + accO[et][1] * accO[et][1]) + (accO[et][2] * accO[et][2] + accO[et][3] * accO[et][3]);
        ss += __shfl_xor(ss, 16); ss += __shfl_xor(ss, 32);
        const float rinv = 1.0f / sqrtf(ss * (1.0f / 128.0f) + EPS);
        const size_t row = (size_t)(rowbase + i);
        u32x2 gv[8];
#pragma unroll
        for (int et = 0; et < 8; ++et) gv[et] = *(const u32x2*)(proj + row * INW + OFF_RG + h * DK + et * 16 + fq * 4);
#pragma unroll
        for (int et = 0; et < 8; ++et) { const int e = h * DK + et * 16 + fq * 4;
            u32x2 o; o.x = pk2(accO[et][0] * rinv * bflo(gv[et].x), accO[et][1] * rinv * bfhi(gv[et].x)); o.y = pk2(accO[et][2] * rinv * bflo(gv[et].y), accO[et][3] * rinv * bfhi(gv[et].y));
            *(u32x2*)(AB + row * LDX + 1024 + e) = o; }
        __syncthreads();
    }
}

__device__ __forceinline__ void final_norm(const Args& a, const Frame& F) {
    const int gw = F.bid * 8 + F.wave, NGW = F.G * 8;
    const bf16_t* xb = (const bf16_t*)(a.ws + WS_XFIN);
    u32x4 nx[4];
    if (gw < MLAT) {
#pragma unroll
        for (int j = 0; j < 4; ++j) nx[j] = *(const u32x4*)(xb + (size_t)gw * D + (j * 64 + F.lane) * 8); }
    for (int m = gw; m < MLAT; m += NGW) {
        float v[4][8]; float s = 0.f;
#pragma unroll
        for (int j = 0; j < 4; ++j) { unpack8(nx[j], v[j]);
#pragma unroll
            for (int e = 0; e < 8; ++e) s += v[j][e] * v[j][e]; }
        const int m2 = m + NGW;
        if (m2 < MLAT) {
#pragma unroll
            for (int j = 0; j < 4; ++j) nx[j] = *(const u32x4*)(xb + (size_t)m2 * D + (j * 64 + F.lane) * 8); }
#pragma unroll
        for (int o = 1; o < 64; o <<= 1) s += __shfl_xor(s, o);
        const float r = 1.0f / sqrtf(s * (1.0f / D) + EPS);
#pragma unroll
        for (int j = 0; j < 4; ++j) { const int col = (j * 64 + F.lane) * 8;
#pragma unroll
            for (int hh = 0; hh < 2; ++hh) { const f32x4 g = *(const f32x4*)(a.final_g + col + 4 * hh); f32x4 o;
#pragma unroll
                for (int e = 0; e < 4; ++e) o[e] = (v[j][4 * hh + e] * r) * g[e];
                *(f32x4*)(a.out + (size_t)m * D + col + 4 * hh) = o; } }
    }
}

#define XB_TMO      128
#define XB_XCNT(j)  (256  + 64 * (j))
#define XB_XSUB(j)  (1280 + 64 * (j))
#define XB_XGEN(j)  (2304 + 64 * (j))
#define XB_TOP      3328
#define XB_TOPGEN   3392
#define XCD_BAR_WORDS 3456
#define XB_SPIN_CAP (1u << 18)
__device__ __forceinline__ unsigned xb_ld(unsigned* p)              { return __hip_atomic_load(p, __ATOMIC_RELAXED, __HIP_MEMORY_SCOPE_AGENT); }
__device__ __forceinline__ unsigned xb_add(unsigned* p, unsigned v) { return __hip_atomic_fetch_add(p, v, __ATOMIC_RELAXED, __HIP_MEMORY_SCOPE_AGENT); }
__device__ __forceinline__ unsigned xb_xcc_id() { return (unsigned)__builtin_amdgcn_s_getreg((3 << 11) | 20) & 0xFu; }
#define XB_SPIN(cond, bar) do { unsigned _sp = 0; while (cond) { __builtin_amdgcn_s_sleep(1); \
    if ((++_sp & 255u) == 0u) { if (xb_ld(&(bar)[XB_TMO])) break; if (_sp > XB_SPIN_CAP) { atomicAdd(&(bar)[XB_TMO], 1u); break; } } } } while (0)
struct XcdBarrier { unsigned* bar; unsigned x; volatile LAS unsigned* st; };
__device__ __forceinline__ XcdBarrier xcd_barrier_post(unsigned* bar, volatile LAS unsigned* st) {
    XcdBarrier b; b.bar = bar; b.x = xb_xcc_id(); b.st = st;
    if (threadIdx.x == 0) (void)xb_add(&bar[XB_XCNT(b.x)], 1u);
    return b;
}
__device__ __forceinline__ void xcd_barrier_complete(unsigned* bar, unsigned x, unsigned& nloc, unsigned& nx) {
    const unsigned G = gridDim.x * gridDim.y * gridDim.z;
    unsigned sum, cnt, mine, sp = 0u;
    for (;;) {
        sum = 0u; cnt = 0u; mine = 0u;
#pragma unroll
        for (unsigned j = 0; j < 16; ++j) { const unsigned c = xb_ld(&bar[XB_XCNT(j)]); sum += c; cnt += (c > 0u) ? 1u : 0u; mine = (j == x) ? c : mine; }
        if (sum == G) break;
        __builtin_amdgcn_s_sleep(1);
        if ((++sp & 255u) == 0u) { if (xb_ld(&bar[XB_TMO])) break; if (sp > XB_SPIN_CAP) { atomicAdd(&bar[XB_TMO], 1u); break; } }
    }
    nloc = mine > 0u ? mine : 1u; nx = cnt > 0u ? cnt : 1u;
}
__device__ __forceinline__ void xcd_barrier(unsigned* bar_, volatile LAS unsigned* st_) {
    XcdBarrier b; b.bar = bar_; b.st = st_; b.x = xb_xcc_id();
    asm volatile("s_waitcnt vmcnt(0)" ::: "memory");
    __syncthreads();
    if (threadIdx.x == 0) {
        unsigned* bar = b.bar;
        __builtin_amdgcn_s_waitcnt(0);
        unsigned nloc = b.st[0], nx = b.st[1];
        if (nloc == 0u) { xcd_barrier_complete(bar, b.x, nloc, nx); b.st[0] = nloc; b.st[1] = nx; }
        const unsigned old = xb_add(&bar[XB_XSUB(b.x)], 1u);
        const unsigned gen = old / nloc;
        if (old + 1u == (gen + 1u) * nloc) {
            __builtin_amdgcn_fence(__ATOMIC_RELEASE, "agent");
            asm volatile("s_waitcnt vmcnt(0)" ::: "memory");
            const unsigned og = xb_add(&bar[XB_TOP], 1u);
            const unsigned tg = og / nx;
            if (og + 1u == (tg + 1u) * nx) xb_add(&bar[XB_TOPGEN], 1u);
            else XB_SPIN(xb_ld(&bar[XB_TOPGEN]) == tg, bar);
            __builtin_amdgcn_fence(__ATOMIC_ACQUIRE, "agent");
            xb_add(&bar[XB_XGEN(b.x)], 1u);
            asm volatile("s_waitcnt vmcnt(0)" ::: "memory");
        } else {
            XB_SPIN(xb_ld(&bar[XB_XGEN(b.x)]) == gen, bar);
            __builtin_amdgcn_fence(__ATOMIC_ACQUIRE, "agent");
            asm volatile("s_waitcnt vmcnt(0)" ::: "memory");
        }
    }
    __syncthreads();
}

constexpr int NPHASE = 16;
__global__ void __launch_bounds__(512, 2) fwd_mega(const float* p_x, const float* p_c, const float* p_ctx, const float* p_cctx, const float* p_wada, const float* p_bada, const float* p_ng,
        const float* p_win, const float* p_wf, const float* p_wp, const float* p_ps, const float* p_dl, const float* p_wuf, const float* p_wup, const float* p_wur, const float* p_wout,
        const float* p_fg, float* p_out, unsigned char* p_ws, int ph_lo, int ph_hi) {
    Args a{p_x, p_c, p_ctx, p_cctx, p_wada, p_bada, p_ng, p_win, p_wf, p_wp, p_ps, p_dl, p_wuf, p_wup, p_wur, p_wout, p_fg, p_out, p_ws, ph_lo, ph_hi};
    extern __shared__ __attribute__((aligned(16))) unsigned char lds_raw[];
    cg::grid_group grid = cg::this_grid();
    Frame F; F.lds = (LAS unsigned char*)lds_raw; F.tid = threadIdx.x; F.lane = F.tid & 63; F.wave = __builtin_amdgcn_readfirstlane(F.tid >> 6); F.G = gridDim.x; F.bid = blockIdx.x;
#define REFRAME() do { int _t = threadIdx.x; asm volatile("" : "+v"(_t)); { unsigned long long _z = 0; asm volatile("" : "+s"(_z)); a.ws = p_ws + _z; } F.tid = _t; F.lane = _t & 63; F.wave = __builtin_amdgcn_readfirstlane(_t >> 6); } while (0)
    const int lo = a.ph_lo, hi = a.ph_hi;
    volatile LAS unsigned* xst = (volatile LAS unsigned*)(F.lds + LDS_BYTES - 64);
    if (F.tid < 4) xst[F.tid] = 0u;
    __syncthreads();
    (void)xcd_barrier_post((unsigned*)(a.ws + WS_BAR), xst);
#define IN(k) (lo <= (k) && (k) < hi)
#define SEAM(k) do { if (IN(k) && IN((k) + 1)) { if (lo < 0) grid.sync(); else xcd_barrier((unsigned*)(a.ws + WS_BAR), (volatile LAS unsigned*)(F.lds + LDS_BYTES - 64)); } } while (0)
    if (IN(0)) {
#ifndef NO_P0
        p0_mod(a, F); REFRAME(); p0_misc(a, F); REFRAME(); weights_layer(a, F, 0, 31, F.bid, F.G);
#endif
    }
    SEAM(0);
    for (int l = 0; l < DEPTH; ++l) {
        const int p = 1 + 7 * l;
        if (IN(p)) {
#ifndef NO_PA
            REFRAME(); if (l == 0) prenorm(a, F, l, 0); else { prenorm_b16(a, F, l); REFRAME(); prenorm(a, F, l, MLAT); } if (l == 1) { __syncthreads(); REFRAME(); weights_layer(a, F, 1, 31, F.bid, F.G); }
#endif
        }
        SEAM(p);
        if (IN(p + 1)) {
#ifndef NO_PB
            pg8::Gemm g{(const bf16_t*)(a.ws + WS_XN), (const bf16_t*)(a.ws + WS_WIN), LDX, LDX, MTOT, INW, D};
            pg8::StaticOrder S;
            if (l == DEPTH - 1) { S.init(MLAT, INW, F.G, F.bid, WGM_IN); S.add_extra(MLAT / 256, OFF_K / 256, (MCTX / 256) * ((OFF_RG - OFF_K) / 256)); }
            else S.init(MTOT, INW, F.G, F.bid, WGM_IN);
            pg8::EpiInProj E{(bf16_t*)(a.ws + WS_PROJ)};
            pg8::gemm_phase<pg8::EpiInProj>(F.lds, g, S, E);
#endif
        }
        SEAM(p + 1);
        if (IN(p + 2)) {
#ifndef NO_KV
            REFRAME(); kv_phase(a, F, l);
#endif
#ifndef NO_F1
            REFRAME(); fourier1(a, F, l);
#endif
#ifndef NO_POOL
            REFRAME(); pool_phase(a, F, l);
#endif
        }
        SEAM(p + 2);
        if (IN(p + 3)) {
#ifndef NO_SCAN
            REFRAME(); scan_phase(a, F, l);
#endif
#ifndef NO_F2
            REFRAME(); fourier2(a, F, l);
#endif
#ifndef NO_RO
            if (l == 0) { REFRAME(); retout_phase(a, F, l, 1, 0); }
#endif
        }
        SEAM(p + 3);
        constexpr int NCTXU = (MCTX / 256) * (D / 256);
        const bool split = (l == 0) && (F.G >= 4 * NCTXU);
        if (IN(p + 4)) {
#ifndef NO_RO
            if (split && F.bid < NCTXU) {
                pg8::Gemm g{(const bf16_t*)(a.ws + WS_XN) + (size_t)MLAT * LDX, (const bf16_t*)(a.ws + WS_WUP), LDX, LDX, MCTX, D, D};
                pg8::StaticOrder S; S.init(MCTX, D, NCTXU, F.bid, 4);
                pg8::EpiUp E{(const bf16_t*)(a.ws + WS_PROJ) + (size_t)MLAT * INW, (bf16_t*)(a.ws + WS_MERGED) + (size_t)MLAT * LDX};
                pg8::gemm_phase<pg8::EpiUp>(F.lds, g, S, E);
            } else { REFRAME(); retout_phase(a, F, l, split ? 2 : 0, NCTXU); }
#endif
        }
        SEAM(p + 4);
        const int Mrows = (l == 0) ? MTOT : MLAT;
        if (IN(p + 5)) {
#ifndef NO_PF
            const int Mup = split ? MLAT : Mrows;
            pg8::Gemm g{(const bf16_t*)(a.ws + WS_XN), (const bf16_t*)(a.ws + WS_WUP), LDX, LDX, Mup, D, D};
            pg8::StaticOrder S; S.init(Mup, D, F.G, F.bid, WGM_UP);
            pg8::EpiUp E{(const bf16_t*)(a.ws + WS_PROJ), (bf16_t*)(a.ws + WS_MERGED)};
            pg8::gemm_phase<pg8::EpiUp>(F.lds, g, S, E);
#endif
        }
        SEAM(p + 5);
        if (IN(p + 6)) {
#ifndef NO_PG
            pg8::Gemm g{(const bf16_t*)(a.ws + WS_MERGED), (const bf16_t*)(a.ws + WS_WOUT), LDX, LDX, Mrows, D, D};
            pg8::StaticOrder S; S.init(Mrows, D, F.G, F.bid, WGM_OUT);
            pg8::EpiOut E{(l == 0) ? a.x : nullptr, (l == 0) ? nullptr : (const bf16_t*)a.out, (l == DEPTH - 1) ? (bf16_t*)(a.ws + WS_XFIN) : (bf16_t*)a.out, a.ctx, (float*)(a.ws + WS_CTX1),
                          (const float*)(a.ws + WS_MOD) + (size_t)l * 5 * 6144};
            pg8::gemm_phase<pg8::EpiOut>(F.lds, g, S, E);
#endif
        }
        SEAM(p + 6);
    }
    if (IN(15)) { REFRAME(); final_norm(a, F); }
#undef IN
#undef SEAM
}

extern "C" void kernel_launch(void* const* d_in, const int* in_sizes, int n_in, void* d_out, int out_size, void* d_ws, size_t ws_size, hipStream_t stream) {
    static int grid = 0;
    if (grid == 0) {
        if (n_in != 17 || out_size != MLAT * D || ws_size < WS_END) { fprintf(stderr, "kernel_launch: unexpected shapes: n_in %d out %d ws %zu (need >= %zu)\n", n_in, out_size, ws_size, (size_t)WS_END); grid = -1; return; }
        int dev = 0, cus = 0, per_cu = 0;
        if (hipGetDevice(&dev) != hipSuccess || hipDeviceGetAttribute(&cus, hipDeviceAttributeMultiprocessorCount, dev) != hipSuccess) { grid = -1; return; }
        if (hipFuncSetAttribute((const void*)fwd_mega, hipFuncAttributeMaxDynamicSharedMemorySize, LDS_BYTES) != hipSuccess) { fprintf(stderr, "kernel_launch: hipFuncSetAttribute failed\n"); grid = -1; return; }
        if (hipOccupancyMaxActiveBlocksPerMultiprocessor(&per_cu, (const void*)fwd_mega, 512, LDS_BYTES) != hipSuccess || per_cu < 1) { fprintf(stderr, "kernel_launch: occupancy query gave %d\n", per_cu); (void)hipGetLastError(); grid = -1; return; }
        grid = cus * per_cu;
        fprintf(stderr, "kernel_launch: grid %d (cus %d x %d)\n", grid, cus, per_cu);
    }
    if (grid < 0) return;
    Args a{};
    a.x = (const float*)d_in[0]; a.c = (const float*)d_in[1]; a.ctx = (const float*)d_in[2]; a.c_ctx = (const float*)d_in[3]; a.w_ada = (const float*)d_in[4]; a.b_ada = (const float*)d_in[5];
    a.norm_g = (const float*)d_in[6]; a.w_in = (const float*)d_in[7]; a.w_fourier = (const float*)d_in[8]; a.w_pool = (const float*)d_in[9]; a.pool_scale = (const float*)d_in[10];
    a.decay_logit = (const float*)d_in[11]; a.w_up_f = (const float*)d_in[12]; a.w_up_p = (const float*)d_in[13]; a.w_up_r = (const float*)d_in[14]; a.w_out = (const float*)d_in[15];
    a.final_g = (const float*)d_in[16]; a.out = (float*)d_out; a.ws = (unsigned char*)d_ws;
    a.ph_lo = 0; a.ph_hi = NPHASE;
    if (hipMemsetAsync((unsigned char*)d_ws + WS_BAR, 0, XCD_BAR_WORDS * 4, stream) != hipSuccess) { fprintf(stderr, "kernel_launch: memset failed\n"); return; }
    void* args[] = {&a.x, &a.c, &a.ctx, &a.c_ctx, &a.w_ada, &a.b_ada, &a.norm_g, &a.w_in, &a.w_fourier, &a.w_pool, &a.pool_scale, &a.decay_logit, &a.w_up_f, &a.w_up_p, &a.w_up_r, &a.w_out,
                    &a.final_g, &a.out, &a.ws, &a.ph_lo, &a.ph_hi};
    hipError_t e = hipLaunchCooperativeKernel((const void*)fwd_mega, dim3(grid), dim3(512), args, LDS_BYTES, stream);
    if (e != hipSuccess) fprintf(stderr, "kernel_launch: cooperative launch failed: %s (grid %d)\n", hipGetErrorString(e), grid);
}
```

```cpp
#include <hip/hip_runtime.h>
#include <hip/hip_cooperative_groups.h>
#include <cstdio>
#include <cstdint>
namespace cg = cooperative_groups;

#define LAS __attribute__((address_space(3)))
typedef unsigned short bf16_t;
typedef short bf16x8 __attribute__((ext_vector_type(8)));
typedef float f32x4 __attribute__((ext_vector_type(4)));
typedef float f32x2 __attribute__((ext_vector_type(2)));
typedef unsigned u32x4 __attribute__((ext_vector_type(4)));
typedef unsigned u32x2 __attribute__((ext_vector_type(2)));

constexpr int D = 2048, NB = 4, SEQ = 4096, CTXL = 256, DEPTH = 2;
constexpr int MLAT = NB * SEQ, MCTX = NB * CTXL, MTOT = MLAT + MCTX;
constexpr int INW = 12288;
constexpr int LDX = 2048 + 64;
constexpr int OFF_FX = 0, OFF_FG = 512, OFF_PX = 1024, OFF_PG = 1536, OFF_Q = 2048, OFF_K = 3072, OFF_V = 4096, OFF_RG = 5120, OFF_MG = 6144;
constexpr int NH = 8, DK = 128, CH = 128;
constexpr int NCH_L = SEQ / CH, NCH_C = CTXL / CH, NCH = NCH_L + NCH_C;
constexpr float EPS = 1e-6f;
constexpr float TWO_PI = 6.283185307179586f;

constexpr size_t MiB = 1u << 20;
constexpr size_t WS_MOD = 0;
constexpr size_t WS_LG = 248 * 1024;
constexpr size_t WS_WCST = 256 * 1024;
constexpr size_t WS_WPT = 512 * 1024;
constexpr size_t WS_A1 = 640 * 1024;
constexpr size_t WS_A3 = 656 * 1024;
constexpr size_t WS_BAR = 704 * 1024;
constexpr size_t WS_WIN = 1 * MiB;
constexpr size_t WS_WUP = 51 * MiB;
constexpr size_t WS_WOUT = 60 * MiB;
constexpr size_t WS_XN = 69 * MiB;
constexpr size_t WS_PROJ = 140 * MiB;
constexpr size_t WS_XFIN = WS_PROJ;
constexpr size_t WS_CTX1 = 548 * MiB;
constexpr size_t WS_KVT = 556 * MiB;
constexpr size_t WS_MERGED = WS_KVT;
constexpr size_t WS_SST = 627 * MiB;
constexpr size_t WS_TP = 695 * MiB;
constexpr size_t WS_END = 730 * MiB;
static_assert(WS_WIN + (size_t)12288 * LDX * 2 <= WS_WUP && WS_WUP + (size_t)2048 * LDX * 2 <= WS_WOUT && WS_WOUT + (size_t)2048 * LDX * 2 <= WS_XN && WS_XN + (size_t)MTOT * LDX * 2 <= WS_PROJ
              && WS_PROJ + (size_t)MTOT * INW * 2 <= WS_CTX1 && WS_MERGED + (size_t)MTOT * LDX * 2 <= WS_SST && WS_KVT + (size_t)32 * 34 * 2 * 16384 * 2 <= WS_SST && WS_SST + (size_t)32 * 34 * 2 * 16384 * 2 <= WS_TP
              && WS_TP + ((size_t)4 * 64 * 512 * 128 + (size_t)4 * 4 * 512 * 128) * 2 <= WS_END, "d_ws map");
constexpr size_t TP_CTX_OFF = (size_t)4 * 64 * 512 * 128;

constexpr int LDS_BYTES = 147456;
constexpr int WGM_IN = 4, WGM_UP = 4, WGM_OUT = 4;

__device__ __forceinline__ unsigned f2bf(float f) { unsigned u = __float_as_uint(f); return (u + 0x7fffu + ((u >> 16) & 1u)) >> 16; }
__device__ __forceinline__ unsigned pk2(float lo, float hi) { return f2bf(lo) | (f2bf(hi) << 16); }
__device__ __forceinline__ float bflo(unsigned w) { return __uint_as_float(w << 16); }
__device__ __forceinline__ float bfhi(unsigned w) { return __uint_as_float(w & 0xffff0000u); }
__device__ __forceinline__ float bf2f(bf16_t b) { return __uint_as_float(((unsigned)b) << 16); }
__device__ __forceinline__ unsigned cvt_pk_bf16(float lo, float hi) { unsigned r; asm volatile("v_cvt_pk_bf16_f32 %0, %1, %2" : "=v"(r) : "v"(lo), "v"(hi)); return r; }
__device__ __forceinline__ float sigmoidf_(float x) { return __builtin_amdgcn_rcpf(1.0f + __expf(-x)); }
__device__ __forceinline__ f32x4 mfma16(bf16x8 a, bf16x8 b, f32x4 c) { return __builtin_amdgcn_mfma_f32_16x16x32_bf16(a, b, c, 0, 0, 0); }
__device__ __forceinline__ bf16x8 as_bf16x8(u32x4 v) { return __builtin_bit_cast(bf16x8, v); }
__device__ __forceinline__ float sin_rev(float r) { return __builtin_amdgcn_sinf(r); }
__device__ __forceinline__ float cos_rev(float r) { return __builtin_amdgcn_cosf(r); }
#define LDS_WAIT() asm volatile("s_waitcnt lgkmcnt(0)" ::: "memory")
__device__ __forceinline__ void unpack8(const u32x4 v, float (&f)[8]) {
    f[0] = bflo(v.x); f[1] = bfhi(v.x); f[2] = bflo(v.y); f[3] = bfhi(v.y); f[4] = bflo(v.z); f[5] = bfhi(v.z); f[6] = bflo(v.w); f[7] = bfhi(v.w);
}
__device__ __forceinline__ u32x4 pack8(const float (&f)[8]) { u32x4 w; w.x = pk2(f[0], f[1]); w.y = pk2(f[2], f[3]); w.z = pk2(f[4], f[5]); w.w = pk2(f[6], f[7]); return w; }
__device__ __forceinline__ unsigned off_b(unsigned row, unsigned ch) { return 256u * row + 16u * (ch ^ (((row & 3) << 2) | ((row >> 2) & 3))); }
__device__ __forceinline__ unsigned tr_addr(unsigned base_row, unsigned c, unsigned lane) { const unsigned q = (lane & 15) >> 2, p = lane & 3; return off_b(base_row + q, 2 * c + (p >> 1)) + 8 * (p & 1); }
__device__ __forceinline__ void tr_read8(unsigned a0, unsigned a1, u32x2 (&r)[2][4]) {
    asm volatile("ds_read_b64_tr_b16 %0, %8\n\tds_read_b64_tr_b16 %1, %8 offset:8192\n\tds_read_b64_tr_b16 %2, %8 offset:16384\n\tds_read_b64_tr_b16 %3, %8 offset:24576\n\t"
                 "ds_read_b64_tr_b16 %4, %9\n\tds_read_b64_tr_b16 %5, %9 offset:8192\n\tds_read_b64_tr_b16 %6, %9 offset:16384\n\tds_read_b64_tr_b16 %7, %9 offset:24576\n\ts_waitcnt lgkmcnt(0)"
                 : "=&v"(r[0][0]), "=&v"(r[0][1]), "=&v"(r[0][2]), "=&v"(r[0][3]), "=&v"(r[1][0]), "=&v"(r[1][1]), "=&v"(r[1][2]), "=&v"(r[1][3]) : "v"(a0), "v"(a1) : "memory");
}

namespace pg8 {
constexpr int BM = 256, BK = 64, HALF = 128, HTB = HALF * BK * 2, STAGE_BYTES = 8 * HTB, NXCD = 8;
__device__ __forceinline__ int lds_byte(int r, int c) { const int st = (r >> 4) * 2 + (c >> 5), rr = r & 15, cc = c & 31, ob = rr * 64 + cc * 2; return st * 1024 + (ob ^ (((ob >> 9) & 1) << 5)); }
__device__ __forceinline__ void stage_rc(int b, int& R, int& C) { const int st = b / 1024, sb = b % 1024, swz = sb ^ (((sb >> 9) & 1) << 5); R = (st >> 1) * 16 + swz / 64; C = (st & 1) * 32 + (swz % 64) / 2; }
__device__ __forceinline__ int perm32(int rho) { const int n = rho >> 4, i = rho & 15; return 8 * (i >> 2) + 4 * n + (i & 3); }

struct Unit { int pm, pn; };
struct Gemm { const bf16_t* A; const bf16_t* Bt; int lda, ldb, M, N, K; };

struct StaticOrder {
    int nM, nN, nwg, G, c, WGM, xpm, xpn, xn;
    __device__ void init(int M, int N, int G_, int c_, int wgm) { nM = M / BM; nN = N / BM; nwg = nM * nN; G = G_; c = c_; WGM = wgm; xn = 0; xpm = 0; xpn = 0; }
    __device__ void add_extra(int pm0, int pn0, int n) { xpm = pm0; xpn = pn0; xn = n; }
    __device__ bool next(int i, Unit& u) const {
        const long L = (long)i * G + c;
        if (L >= nwg) { const int e = (int)(L - nwg); if (e >= xn) return false; u.pm = xpm + (e & 3); u.pn = xpn + (e >> 2); return true; }
        int wgid = (int)L; { const int q = nwg / NXCD, r = nwg % NXCD, xcd = wgid % NXCD, off = wgid / NXCD; wgid = (xcd < r ? xcd * (q + 1) : r * (q + 1) + (xcd - r) * q) + off; }
        const int nig = WGM * nN, gid = wgid / nig, fm = gid * WGM, gsz = (nM - fm) < WGM ? (nM - fm) : WGM;
        u.pm = fm + ((wgid % nig) % gsz); u.pn = (wgid % nig) / gsz; return true;
    }
};

template <class Epi>
__device__ __forceinline__ void gemm_phase(LAS unsigned char* lds, const Gemm g, const StaticOrder& S, const Epi& E) {
    int tid = threadIdx.x; asm volatile("" : "+v"(tid));
    const int wid = __builtin_amdgcn_readfirstlane(tid >> 6), lane = tid & 63, wr = wid >> 2, wc = wid & 3, fr = lane & 15, fq = lane >> 4;
    const int K = g.K, nt = K / BK;
    unsigned voffA[2], voffB[2];
#pragma unroll
    for (int i = 0; i < 2; ++i) { int R, C; stage_rc(tid * 16 + i * 8192, R, C); const int Rb = Epi::PERM ? ((R & ~31) + perm32(R & 31)) : R;
        voffA[i] = (unsigned)(R * g.lda + C) * 2u; voffB[i] = (unsigned)(Rb * g.ldb + C) * 2u; }
    const size_t kstep = (size_t)(BK * 2);
    const size_t hstepA = (size_t)HALF * g.lda * 2, hstepB = (size_t)HALF * g.ldb * 2;
    const size_t tstepA = 2 * hstepA, tstepB = 2 * hstepB;
    const unsigned ldsw = (unsigned)wid * 1024u;
    const int aoff = lds_byte(wr * 64 + fr, fq * 8), boff = lds_byte(wc * 32 + fr, fq * 8);
#define PG8_SA(b, h) (((b) * 2 + (h)) * HTB)
#define PG8_SB(b, h) ((4 + (b) * 2 + (h)) * HTB)
#define PG8_STAGE(bufoff, gbase, voff) do { _Pragma("unroll") for (int _i = 0; _i < 2; ++_i) \
        __builtin_amdgcn_global_load_lds((const unsigned*)((const char*)(gbase) + (voff)[_i]), (LAS unsigned*)(lds + (bufoff) + ldsw + _i * 8192), 16, 0, 0); } while (0)
#define PG8_LDA(dst, b, h) do { _Pragma("unroll") for (int m = 0; m < 4; ++m) _Pragma("unroll") for (int k = 0; k < 2; ++k) dst[m][k] = *(const LAS bf16x8*)(lds + PG8_SA(b, h) + aoff + m * 2048 + k * 1024); } while (0)
#define PG8_LDB(dst, b, h) do { _Pragma("unroll") for (int n = 0; n < 2; ++n) _Pragma("unroll") for (int k = 0; k < 2; ++k) dst[n][k] = *(const LAS bf16x8*)(lds + PG8_SB(b, h) + boff + n * 2048 + k * 1024); } while (0)
#define PG8_MMA(ai, bj, At, Bt) do { __builtin_amdgcn_s_setprio(1); _Pragma("unroll") for (int m = 0; m < 4; ++m) _Pragma("unroll") for (int n = 0; n < 2; ++n) _Pragma("unroll") for (int k = 0; k < 2; ++k) \
        acc[ai][bj][m][n] = __builtin_amdgcn_mfma_f32_16x16x32_bf16(Bt[n][k], At[m][k], acc[ai][bj][m][n], 0, 0, 0); __builtin_amdgcn_s_setprio(0); } while (0)
#define PG8_WAIT_V(n) asm volatile("s_waitcnt vmcnt(" #n ")" ::: "memory")
#define PG8_WAIT_L(n) asm volatile("s_waitcnt lgkmcnt(" #n ")" ::: "memory")
#define PG8_BAR __builtin_amdgcn_s_barrier()
#define PG8_SCHED __builtin_amdgcn_sched_barrier(0)
    Unit cur, nxt; int ui = 0;
    if (!S.next(0, cur)) return;
    f32x4 acc[2][2][4][2];
#pragma unroll
    for (int a = 0; a < 2; ++a)
#pragma unroll
        for (int b = 0; b < 2; ++b)
#pragma unroll
            for (int m = 0; m < 4; ++m)
#pragma unroll
                for (int n = 0; n < 2; ++n) acc[a][b][m][n] = (f32x4){0.f, 0.f, 0.f, 0.f};
    bf16x8 At[4][2], B0[2][2], B1[2][2];
    const char* cA = (const char*)g.A + (size_t)cur.pm * tstepA; const char* cB = (const char*)g.Bt + (size_t)cur.pn * tstepB;
    PG8_STAGE(PG8_SB(0, 0), cB, voffB); PG8_STAGE(PG8_SB(0, 1), cB + hstepB, voffB); PG8_STAGE(PG8_SA(0, 0), cA, voffA); PG8_STAGE(PG8_SA(0, 1), cA + hstepA, voffA);
    if (wr == 1) PG8_BAR;
    PG8_WAIT_V(2); PG8_BAR;
    PG8_STAGE(PG8_SB(1, 0), cB + kstep, voffB); PG8_STAGE(PG8_SA(1, 0), cA + kstep, voffA); PG8_STAGE(PG8_SB(1, 1), cB + hstepB + kstep, voffB);
    PG8_WAIT_V(6); PG8_BAR;
    for (;;) {
        const bool has_next = S.next(ui + 1, nxt);
        const char* nA = has_next ? (const char*)g.A + (size_t)nxt.pm * tstepA : cA; const char* nB = has_next ? (const char*)g.Bt + (size_t)nxt.pn * tstepB : cB;
#pragma unroll 1
        for (int seg = 0; seg < (Epi::MIDK ? 3 : 1); ++seg) {
        const int t0 = Epi::MIDK ? seg * 8 : 0, t1 = Epi::MIDK ? (seg == 2 ? nt : seg * 8 + 8) : nt;
        if constexpr (Epi::MIDK) { if (seg > 0) { PG8_SCHED;
            asm volatile("s_cmp_lg_u32 %0, 0\n\ts_cbranch_scc1 1f\n\ts_barrier\n1:" :: "s"(wr) : "memory", "scc");
            E.mid(acc, cur, t0, wr, wc, fr, fq);
            asm volatile("s_cmp_lg_u32 %0, 1\n\ts_cbranch_scc1 1f\n\ts_barrier\n1:" :: "s"(wr) : "memory", "scc");
            PG8_SCHED; } }
#pragma unroll 1
        for (int t = t0; t < t1; t += 2) {
            const bool last = (t == nt - 2);
            const char* a1 = cA + (size_t)(t + 1) * kstep;
            const char* a2 = last ? nA : cA + (size_t)(t + 2) * kstep; const char* b2 = last ? nB : cB + (size_t)(t + 2) * kstep;
            const char* a3 = a2 + kstep; const char* b3 = b2 + kstep;
            PG8_LDB(B0, 0, 0); PG8_LDB(B1, 0, 1); PG8_SCHED; PG8_LDA(At, 0, 0); PG8_STAGE(PG8_SA(1, 1), a1 + hstepA, voffA);
            PG8_WAIT_V(8); PG8_WAIT_L(0); PG8_BAR; PG8_MMA(0, 0, At, B0); PG8_MMA(0, 1, At, B1); PG8_BAR; PG8_SCHED;
            PG8_LDA(At, 0, 1); PG8_STAGE(PG8_SB(0, 0), b2, voffB); PG8_STAGE(PG8_SB(0, 1), b2 + hstepB, voffB); PG8_STAGE(PG8_SA(0, 0), a2, voffA);
            PG8_WAIT_V(8); PG8_WAIT_L(0); PG8_BAR; PG8_MMA(1, 0, At, B0); PG8_MMA(1, 1, At, B1); PG8_BAR; PG8_SCHED;
            PG8_LDB(B0, 1, 0); PG8_LDB(B1, 1, 1); PG8_SCHED; PG8_LDA(At, 1, 0); PG8_STAGE(PG8_SA(0, 1), a2 + hstepA, voffA);
            PG8_WAIT_V(8); PG8_WAIT_L(0); PG8_BAR; PG8_MMA(0, 0, At, B0); PG8_MMA(0, 1, At, B1); PG8_BAR; PG8_SCHED;
            PG8_LDA(At, 1, 1); PG8_STAGE(PG8_SB(1, 0), b3, voffB); PG8_STAGE(PG8_SB(1, 1), b3 + hstepB, voffB); PG8_STAGE(PG8_SA(1, 0), a3, voffA);
            PG8_WAIT_V(8); PG8_WAIT_L(0); PG8_BAR; PG8_MMA(1, 0, At, B0); PG8_MMA(1, 1, At, B1); PG8_BAR; PG8_SCHED;
        }
        }
        if (wr == 0) PG8_BAR;
        E(acc, cur, wr, wc, fr, fq);
        if (!has_next) break;
#pragma unroll
        for (int a = 0; a < 2; ++a)
#pragma unroll
            for (int b = 0; b < 2; ++b)
#pragma unroll
                for (int m = 0; m < 4; ++m)
#pragma unroll
                    for (int n = 0; n < 2; ++n) acc[a][b][m][n] = (f32x4){0.f, 0.f, 0.f, 0.f};
        cur = nxt; cA = nA; cB = nB; ++ui;
        if (wr == 1) PG8_BAR;
    }
    PG8_WAIT_V(0);
    PG8_BAR;
#undef PG8_SA
#undef PG8_SB
#undef PG8_STAGE
#undef PG8_LDA
#undef PG8_LDB
#undef PG8_MMA
#undef PG8_WAIT_V
#undef PG8_WAIT_L
#undef PG8_BAR
#undef PG8_SCHED
}

struct EpiInProj {
    static constexpr bool PERM = true, MIDK = false;
    bf16_t* O;
    __device__ __forceinline__ void mid(f32x4 (&)[2][2][4][2], const Unit&, int, int, int, int, int) const {}
    __device__ __forceinline__ void operator()(const f32x4 (&acc)[2][2][4][2], const Unit& u, int wr, int wc, int fr, int fq) const {
        const int pn = u.pn;
        int act = 0;
        if (pn >= 24) act = 2; else if ((pn >= 2 && pn < 4) || (pn >= 6 && pn < 8) || (pn >= 20)) act = 1; else if (pn >= 8 && pn < 12) act = 3;
        int row0 = u.pm * BM + wr * 64 + fr, col0 = pn * BM + wc * 32 + 8 * fq; asm volatile("" : "+v"(row0), "+v"(col0));
#pragma unroll
        for (int ai = 0; ai < 2; ++ai)
#pragma unroll
            for (int m = 0; m < 4; ++m) { bf16_t* rowp = O + (size_t)(row0 + ai * HALF + m * 16) * INW + col0;
#pragma unroll
                for (int bj = 0; bj < 2; ++bj) { f32x4 v0 = acc[ai][bj][m][0], v1 = acc[ai][bj][m][1];
                    if (act == 1) {
#pragma unroll
                        for (int j = 0; j < 4; ++j) { v0[j] = v0[j] * sigmoidf_(v0[j]); v1[j] = v1[j] * sigmoidf_(v1[j]); } }
                    else if (act == 2) {
#pragma unroll
                        for (int j = 0; j < 4; ++j) { v0[j] = sigmoidf_(v0[j]); v1[j] = sigmoidf_(v1[j]); } }
                    else if (act == 3) { v0 = v0 * 0.08838834764831845f; v1 = v1 * 0.08838834764831845f; }
                    u32x4 w; w.x = cvt_pk_bf16(v0[0], v0[1]); w.y = cvt_pk_bf16(v0[2], v0[3]); w.z = cvt_pk_bf16(v1[0], v1[1]); w.w = cvt_pk_bf16(v1[2], v1[3]);
                    *(u32x4*)(rowp + bj * HALF) = w; } }
    }
};

struct EpiUp {
    static constexpr bool PERM = true, MIDK = true;
    const bf16_t* P;
    bf16_t* O;
    __device__ __forceinline__ void mid(f32x4 (&acc)[2][2][4][2], const Unit& u, int t, int wr, int wc, int fr, int fq) const {
        const int br = (t == 8) ? 0 : 1;
        int row0 = u.pm * BM + wr * 64 + fr, col0 = u.pn * BM + wc * 32 + 8 * fq; asm volatile("" : "+v"(row0), "+v"(col0));
#pragma unroll
        for (int ai = 0; ai < 2; ++ai) {
            u32x4 ga[4][2], gb[4][2];
#pragma unroll
            for (int m = 0; m < 4; ++m) { const bf16_t* gp = P + (size_t)(row0 + ai * HALF + m * 16) * INW + OFF_MG + br * 2048 + col0;
#pragma unroll
                for (int bj = 0; bj < 2; ++bj) { ga[m][bj] = *(const u32x4*)(gp + bj * HALF); gb[m][bj] = *(const u32x4*)(gp + 2048 + bj * HALF); } }
#pragma unroll
            for (int m = 0; m < 4; ++m)
#pragma unroll
                for (int bj = 0; bj < 2; ++bj) { const u32x4 a_ = ga[m][bj], b_ = gb[m][bj];
                    f32x4 r0, r1;
                    r0[0] = bflo(a_.x) * __builtin_amdgcn_rcpf(bflo(b_.x)); r0[1] = bfhi(a_.x) * __builtin_amdgcn_rcpf(bfhi(b_.x));
                    r0[2] = bflo(a_.y) * __builtin_amdgcn_rcpf(bflo(b_.y)); r0[3] = bfhi(a_.y) * __builtin_amdgcn_rcpf(bfhi(b_.y));
                    r1[0] = bflo(a_.z) * __builtin_amdgcn_rcpf(bflo(b_.z)); r1[1] = bfhi(a_.z) * __builtin_amdgcn_rcpf(bfhi(b_.z));
                    r1[2] = bflo(a_.w) * __builtin_amdgcn_rcpf(bflo(b_.w)); r1[3] = bfhi(a_.w) * __builtin_amdgcn_rcpf(bfhi(b_.w));
                    acc[ai][bj][m][0] = acc[ai][bj][m][0] * r0; acc[ai][bj][m][1] = acc[ai][bj][m][1] * r1; }
            asm volatile("" ::: "memory"); }
    }
    __device__ __forceinline__ void operator()(const f32x4 (&acc)[2][2][4][2], const Unit& u, int wr, int wc, int fr, int fq) const {
        int row0 = u.pm * BM + wr * 64 + fr, col0 = u.pn * BM + wc * 32 + 8 * fq; asm volatile("" : "+v"(row0), "+v"(col0));
#pragma unroll
        for (int ai = 0; ai < 2; ++ai) {
            u32x4 gc[4][2];
#pragma unroll
            for (int m = 0; m < 4; ++m) { const bf16_t* gp = P + (size_t)(row0 + ai * HALF + m * 16) * INW + OFF_MG + 2 * 2048 + col0;
#pragma unroll
                for (int bj = 0; bj < 2; ++bj) gc[m][bj] = *(const u32x4*)(gp + bj * HALF); }
#pragma unroll
            for (int m = 0; m < 4; ++m) { bf16_t* rowp = O + (size_t)(row0 + ai * HALF + m * 16) * LDX + col0;
#pragma unroll
                for (int bj = 0; bj < 2; ++bj) { const u32x4 g_ = gc[m][bj];
                    const f32x4 v0 = acc[ai][bj][m][0], v1 = acc[ai][bj][m][1];
                    u32x4 w; w.x = cvt_pk_bf16(v0[0] * bflo(g_.x), v0[1] * bfhi(g_.x)); w.y = cvt_pk_bf16(v0[2] * bflo(g_.y), v0[3] * bfhi(g_.y));
                    w.z = cvt_pk_bf16(v1[0] * bflo(g_.z), v1[1] * bfhi(g_.z)); w.w = cvt_pk_bf16(v1[2] * bflo(g_.w), v1[3] * bfhi(g_.w));
                    *(u32x4*)(rowp + bj * HALF) = w; } }
            asm volatile("" ::: "memory"); }
    }
};

struct EpiOut {
    static constexpr bool PERM = true, MIDK = false;
    const float* xold_f32; const bf16_t* xold_b16; bf16_t* xnew_b16; const float* xold_ctx; float* xnew_ctx; const float* mod;
    __device__ __forceinline__ void mid(f32x4 (&)[2][2][4][2], const Unit&, int, int, int, int, int) const {}
    __device__ __forceinline__ void operator()(const f32x4 (&acc)[2][2][4][2], const Unit& u, int wr, int wc, int fr, int fq) const {
        const bool isctx = u.pm >= (MLAT / BM);
        const int mrow = isctx ? 4 : (u.pm >> 4);
        int row0 = u.pm * BM + wr * 64 + fr, col0 = u.pn * BM + wc * 32 + 8 * fq; asm volatile("" : "+v"(row0), "+v"(col0));
        f32x4 gv[2][2];
#pragma unroll
        for (int bj = 0; bj < 2; ++bj)
#pragma unroll
            for (int n = 0; n < 2; ++n) gv[bj][n] = *(const f32x4*)(mod + mrow * 6144 + 4096 + col0 + bj * HALF + n * 4);
        if (isctx) {
            const float* xo = xold_ctx - (size_t)MLAT * D; float* xn = xnew_ctx - (size_t)MLAT * D;
#pragma unroll
            for (int am = 0; am < 4; ++am) {
                const int ai = am >> 1, mb = (am & 1) * 2;
                f32x4 xv[2][2][2];
#pragma unroll
                for (int mm = 0; mm < 2; ++mm) { const size_t off = (size_t)(row0 + ai * HALF + (mb + mm) * 16) * D + col0;
#pragma unroll
                    for (int bj = 0; bj < 2; ++bj)
#pragma unroll
                        for (int n = 0; n < 2; ++n) xv[mm][bj][n] = *(const f32x4*)(xo + off + bj * HALF + n * 4); }
#pragma unroll
                for (int mm = 0; mm < 2; ++mm) { const size_t off = (size_t)(row0 + ai * HALF + (mb + mm) * 16) * D + col0;
#pragma unroll
                    for (int bj = 0; bj < 2; ++bj)
#pragma unroll
                        for (int n = 0; n < 2; ++n) *(f32x4*)(xn + off + bj * HALF + n * 4) = xv[mm][bj][n] + gv[bj][n] * acc[ai][bj][mb + mm][n]; }
                asm volatile("" ::: "memory"); }
        } else if (xold_b16) {
#pragma unroll
            for (int ai = 0; ai < 2; ++ai) {
                u32x4 xb[4][2];
#pragma unroll
                for (int m = 0; m < 4; ++m) { const size_t off = (size_t)(row0 + ai * HALF + m * 16) * D + col0;
#pragma unroll
                    for (int bj = 0; bj < 2; ++bj) xb[m][bj] = *(const u32x4*)(xold_b16 + off + bj * HALF); }
#pragma unroll
                for (int m = 0; m < 4; ++m) { const size_t off = (size_t)(row0 + ai * HALF + m * 16) * D + col0;
#pragma unroll
                    for (int bj = 0; bj < 2; ++bj) { const u32x4 x_ = xb[m][bj]; const f32x4 a0 = acc[ai][bj][m][0], a1 = acc[ai][bj][m][1], g0 = gv[bj][0], g1 = gv[bj][1];
                        u32x4 w; w.x = cvt_pk_bf16(bflo(x_.x) + g0[0] * a0[0], bfhi(x_.x) + g0[1] * a0[1]); w.y = cvt_pk_bf16(bflo(x_.y) + g0[2] * a0[2], bfhi(x_.y) + g0[3] * a0[3]);
                        w.z = cvt_pk_bf16(bflo(x_.z) + g1[0] * a1[0], bfhi(x_.z) + g1[1] * a1[1]); w.w = cvt_pk_bf16(bflo(x_.w) + g1[2] * a1[2], bfhi(x_.w) + g1[3] * a1[3]);
                        *(u32x4*)(xnew_b16 + off + bj * HALF) = w; } }
                asm volatile("" ::: "memory"); }
        } else {
#pragma unroll
            for (int am = 0; am < 4; ++am) {
                const int ai = am >> 1, mb = (am & 1) * 2;
                f32x4 xv[2][2][2];
#pragma unroll
                for (int mm = 0; mm < 2; ++mm) { const size_t off = (size_t)(row0 + ai * HALF + (mb + mm) * 16) * D + col0;
#pragma unroll
                    for (int bj = 0; bj < 2; ++bj)
#pragma unroll
                        for (int n = 0; n < 2; ++n) xv[mm][bj][n] = *(const f32x4*)(xold_f32 + off + bj * HALF + n * 4); }
#pragma unroll
                for (int mm = 0; mm < 2; ++mm) { const size_t off = (size_t)(row0 + ai * HALF + (mb + mm) * 16) * D + col0;
#pragma unroll
                    for (int bj = 0; bj < 2; ++bj) { const f32x4 v0 = xv[mm][bj][0] + gv[bj][0] * acc[ai][bj][mb + mm][0], v1 = xv[mm][bj][1] + gv[bj][1] * acc[ai][bj][mb + mm][1];
                        u32x4 w; w.x = cvt_pk_bf16(v0[0], v0[1]); w.y = cvt_pk_bf16(v0[2], v0[3]); w.z = cvt_pk_bf16(v1[0], v1[1]); w.w = cvt_pk_bf16(v1[2], v1[3]);
                        *(u32x4*)(xnew_b16 + off + bj * HALF) = w; } }
                asm volatile("" ::: "memory"); }
        }
    }
};
}

struct Args {
    const float* x; const float* c; const float* ctx; const float* c_ctx; const float* w_ada; const float* b_ada; const float* norm_g; const float* w_in;
    const float* w_fourier; const float* w_pool; const float* pool_scale; const float* decay_logit; const float* w_up_f; const float* w_up_p; const float* w_up_r;
    const float* w_out; const float* final_g; float* out; unsigned char* ws;
    int ph_lo, ph_hi;
};

struct Frame {
    LAS unsigned char* lds; int tid, lane, wave, G, bid;
};

__device__ __forceinline__ void transpose_item(const float* W, int N, bf16_t* WT, int ldo, int koff, LAS float* scr, int item, int lane) {
    const int nblk = N / 64, kb = item / nblk, nb = item % nblk, k0 = 64 * kb, n0 = 64 * nb;
    float wv[64];
#pragma unroll
    for (int i = 0; i < 64; ++i) wv[i] = W[(size_t)(k0 + i) * N + n0 + lane];
#pragma unroll
    for (int i = 0; i < 64; ++i) scr[i * 65 + lane] = wv[i];
    LDS_WAIT();
    const int c = lane & 7;
#pragma unroll
    for (int j = 0; j < 8; ++j) { const int n = (lane >> 3) + 8 * j; const LAS float* s_ = scr + (8 * c) * 65 + n;
        u32x4 o; o.x = pk2(s_[0 * 65], s_[1 * 65]); o.y = pk2(s_[2 * 65], s_[3 * 65]); o.z = pk2(s_[4 * 65], s_[5 * 65]); o.w = pk2(s_[6 * 65], s_[7 * 65]);
        *(u32x4*)(WT + (size_t)(n0 + n) * ldo + koff + k0 + 8 * c) = o; }
    LDS_WAIT();
}

__device__ __forceinline__ void weights_layer(const Args& a, const Frame& F, int l, int parts, int widx, int nwk) {
    LAS float* scr = (LAS float*)(F.lds + F.wave * 16640);
    const int gw = widx * 8 + F.wave, NGW = nwk * 8;
    bf16_t* WIN = (bf16_t*)(a.ws + WS_WIN); bf16_t* WUP = (bf16_t*)(a.ws + WS_WUP); bf16_t* WOUT = (bf16_t*)(a.ws + WS_WOUT);
    constexpr int I_IN = 32 * 192, I_UF = 8 * 32, I_UP = 8 * 32, I_UR = 16 * 32, I_O = 32 * 32;
    if (parts & 1) for (int it = gw; it < I_IN / 2; it += NGW) transpose_item(a.w_in + (size_t)l * D * INW, INW, WIN, LDX, 0, scr, it, F.lane);
    if (parts & 16) for (int it = I_IN / 2 + gw; it < I_IN; it += NGW) transpose_item(a.w_in + (size_t)l * D * INW, INW, WIN, LDX, 0, scr, it, F.lane);
    if (parts & 2) for (int it = gw; it < I_UF + I_UP + I_UR; it += NGW) {
        int r = it;
        if (r < I_UF) { transpose_item(a.w_up_f + (size_t)l * 512 * D, D, WUP, LDX, 0, scr, r, F.lane); continue; } r -= I_UF;
        if (r < I_UP) { transpose_item(a.w_up_p + (size_t)l * 512 * D, D, WUP, LDX, 512, scr, r, F.lane); continue; } r -= I_UP;
        transpose_item(a.w_up_r + (size_t)l * 1024 * D, D, WUP, LDX, 1024, scr, r, F.lane);
    }
    if (parts & 4) for (int it = gw; it < I_O; it += NGW) transpose_item(a.w_out + (size_t)l * D * D, D, WOUT, LDX, 0, scr, it, F.lane);
    if (parts & 8) {
        const int gt = widx * 512 + F.tid, NT = nwk * 512;
        bf16_t* WCST = (bf16_t*)(a.ws + WS_WCST); bf16_t* WPT = (bf16_t*)(a.ws + WS_WPT);
        const float* wf = a.w_fourier + (size_t)l * 4 * 128 * 128; const float* wp = a.w_pool + (size_t)l * 4 * 128 * 128;
        for (int o = gt; o < 4 * 8 * 128 * 32; o += NT) {
            const int jj = o & 7, fq = (o >> 3) & 3, d = (o >> 5) & 127, cbk = (o >> 12) & 7, g = o >> 15;
            const int cch = cbk * 16 + fq * 4 + (jj & 3); const bool is_sin = jj >= 4;
            float s = 0.f;
            for (int dp = 0; dp < 128; ++dp) { const float rev = (float)((cch * dp) & 127) * (1.0f / 128.0f);
                const float tw = is_sin ? sin_rev(rev) : cos_rev(rev); s += tw * wf[(g * 128 + dp) * 128 + d]; }
            WCST[o] = (bf16_t)f2bf(s * 0.08838834764831845f);
        }
        for (int o = gt; o < 4 * 128 * 128; o += NT) { const int cch = o & 127, d = (o >> 7) & 127, g = o >> 14; WPT[o] = (bf16_t)f2bf(wp[(g * 128 + cch) * 128 + d]); }
    }
}

__device__ __forceinline__ void p0_misc(const Args& a, const Frame& F) {
    const int gt = F.bid * 512 + F.tid, NT = F.G * 512;
    bf16_t* A1 = (bf16_t*)(a.ws + WS_A1); bf16_t* A3 = (bf16_t*)(a.ws + WS_A3); float* LG = (float*)(a.ws + WS_LG);
    for (int o = gt; o < 128 * 64; o += NT) { const int aa = o & 63, r = o >> 6, m1 = r & 63; const float rev = (float)((m1 * aa) & 63) * (1.0f / 64.0f);
        A1[o] = (bf16_t)f2bf(r < 64 ? cos_rev(rev) : -sin_rev(rev)); }
    for (int o = gt; o < 128 * 128; o += NT) { const int k = o & 127, r = o >> 7, m2 = r & 63, n2 = k >> 1, ri = k & 1; const float rev = (float)((m2 * n2) & 63) * (1.0f / 64.0f);
        const float cs = cos_rev(rev), sn = sin_rev(rev);
        const float v = (r < 64) ? (ri == 0 ? cs : sn) : (ri == 0 ? -sn : cs);
        A3[o] = (bf16_t)f2bf(v); }
    for (int o = gt; o < 32; o += NT) { const float z = a.decay_logit[o]; LG[o] = -log1pf(expf(-z)); }
}

__device__ __forceinline__ void p0_mod(const Args& a, const Frame& F) {
    LAS float* sc = (LAS float*)F.lds;
    LAS float* red = (LAS float*)(F.lds + 5 * 2048 * 4);
    float* MOD = (float*)(a.ws + WS_MOD);
    bool have = false;
    for (int it = F.bid; it < 2 * 96; it += F.G) {
        if (!have) {
            for (int o = F.tid; o < 5 * 2048; o += 512) { const float v = (o < 4 * 2048) ? a.c[o] : a.c_ctx[o - 4 * 2048]; sc[o] = v * sigmoidf_(v); }
            have = true;
        }
        __syncthreads();
        const int l = it / 96, cg0 = (it % 96) * 64;
        const int cq = F.tid & 15, ks = F.tid >> 4;
        const float* W = a.w_ada + (size_t)l * D * 6144 + cg0 + cq * 4;
        f32x4 ac[5];
#pragma unroll
        for (int r = 0; r < 5; ++r) ac[r] = (f32x4){0.f, 0.f, 0.f, 0.f};
#pragma unroll 16
        for (int kk = 0; kk < 64; ++kk) { const int k = ks * 64 + kk; const f32x4 w = *(const f32x4*)(W + (size_t)k * 6144);
#pragma unroll
            for (int r = 0; r < 5; ++r) ac[r] += w * sc[r * 2048 + k]; }
#pragma unroll
        for (int r = 0; r < 5; ++r)
#pragma unroll
            for (int j = 0; j < 4; ++j) red[(ks * 16 + cq) * 20 + r * 4 + j] = ac[r][j];
        __syncthreads();
        if (F.tid < 320) { const int cq2 = F.tid / 20, rj = F.tid % 20, r = rj >> 2, j = rj & 3; float s = 0.f;
            for (int k2 = 0; k2 < 32; ++k2) s += red[(k2 * 16 + cq2) * 20 + rj];
            const int col = cg0 + cq2 * 4 + j;
            MOD[(l * 5 + r) * 6144 + col] = s + a.b_ada[l * 6144 + col]; }
        __syncthreads();
    }
}

__device__ __forceinline__ void prenorm_b16(const Args& a, const Frame& F, int l) {
    const int gw = F.bid * 8 + F.wave, NGW = F.G * 8;
    const float* MOD = (const float*)(a.ws + WS_MOD) + (size_t)l * 5 * 6144;
    const bf16_t* xb = (const bf16_t*)a.out; const float* ng = a.norm_g + (size_t)l * D;
    bf16_t* XN = (bf16_t*)(a.ws + WS_XN);
    u32x4 nx[4];
    if (gw < MLAT) {
#pragma unroll
        for (int j = 0; j < 4; ++j) nx[j] = *(const u32x4*)(xb + (size_t)gw * D + (j * 64 + F.lane) * 8); }
    for (int m = gw; m < MLAT; m += NGW) {
        const int mrow = m >> 12;
        float v[4][8]; float s = 0.f;
#pragma unroll
        for (int j = 0; j < 4; ++j) { unpack8(nx[j], v[j]);
#pragma unroll
            for (int e = 0; e < 8; ++e) s += v[j][e] * v[j][e]; }
        const int m2 = m + NGW;
        if (m2 < MLAT) {
#pragma unroll
            for (int j = 0; j < 4; ++j) nx[j] = *(const u32x4*)(xb + (size_t)m2 * D + (j * 64 + F.lane) * 8); }
#pragma unroll
        for (int o = 1; o < 64; o <<= 1) s += __shfl_xor(s, o);
        const float r = 1.0f / sqrtf(s * (1.0f / D) + EPS);
#pragma unroll
        for (int j = 0; j < 4; ++j) { const int col = (j * 64 + F.lane) * 8; float h[8];
#pragma unroll
            for (int hh = 0; hh < 2; ++hh) { const f32x4 g = *(const f32x4*)(ng + col + 4 * hh), sh = *(const f32x4*)(MOD + mrow * 6144 + col + 4 * hh), sc = *(const f32x4*)(MOD + mrow * 6144 + 2048 + col + 4 * hh);
#pragma unroll
                for (int e = 0; e < 4; ++e) h[4 * hh + e] = (v[j][4 * hh + e] * r) * g[e] * (sc[e] + 1.0f) + sh[e]; }
            *(u32x4*)(XN + (size_t)m * LDX + col) = pack8(h); }
    }
}
__device__ __forceinline__ void prenorm(const Args& a, const Frame& F, int l, int m_lo) {
    const int gw = m_lo + F.bid * 8 + F.wave, NGW = F.G * 8;
    const float* MOD = (const float*)(a.ws + WS_MOD) + (size_t)l * 5 * 6144;
    const float* xl = (l == 0) ? a.x : a.out; const float* xc = (l == 0) ? a.ctx : (const float*)(a.ws + WS_CTX1);
    const float* ng = a.norm_g + (size_t)l * D;
    bf16_t* XN = (bf16_t*)(a.ws + WS_XN);
    f32x4 v[8], nx[8];
    if (gw < MTOT) { const f32x4* xr = (const f32x4*)(gw >= MLAT ? xc + (size_t)(gw - MLAT) * D : xl + (size_t)gw * D) + F.lane;
#pragma unroll
        for (int j = 0; j < 8; ++j) nx[j] = xr[64 * j]; }
    for (int m = gw; m < MTOT; m += NGW) {
        const bool isctx = m >= MLAT; const int mrow = isctx ? 4 : (m >> 12);
#pragma unroll
        for (int j = 0; j < 8; ++j) v[j] = nx[j];
        const int m2 = m + NGW;
        if (m2 < MTOT) { const f32x4* xr = (const f32x4*)(m2 >= MLAT ? xc + (size_t)(m2 - MLAT) * D : xl + (size_t)m2 * D) + F.lane;
#pragma unroll
            for (int j = 0; j < 8; ++j) nx[j] = xr[64 * j]; }
        float s = 0.f;
#pragma unroll
        for (int j = 0; j < 8; ++j) s += (v[j].x * v[j].x + v[j].y * v[j].y) + (v[j].z * v[j].z + v[j].w * v[j].w);
#pragma unroll
        for (int o = 1; o < 64; o <<= 1) s += __shfl_xor(s, o);
        const float r = 1.0f / sqrtf(s * (1.0f / D) + EPS);
        const f32x4* gp = (const f32x4*)ng + F.lane; const f32x4* shp = (const f32x4*)(MOD + mrow * 6144) + F.lane; const f32x4* scp = (const f32x4*)(MOD + mrow * 6144 + 2048) + F.lane;
        u32x2* o8 = (u32x2*)(XN + (size_t)m * LDX) + F.lane;
#pragma unroll
        for (int j = 0; j < 8; ++j) { const f32x4 g = gp[64 * j], sh = shp[64 * j], sc = scp[64 * j];
            const f32x4 h = (v[j] * r) * g * (sc + 1.0f) + sh;
            u32x2 w; w.x = pk2(h.x, h.y); w.y = pk2(h.z, h.w); o8[64 * j] = w; }
    }
}

constexpr int LDP = 136;
__device__ __forceinline__ void chunk_decode(int it, int& b, int& h, int& cc, int& rowbase, bool& is_lat, int& posbase) {
    const int bh = it / NCH; cc = it % NCH; b = bh >> 3; h = bh & 7;
    if (cc < NCH_C) { is_lat = false; rowbase = MLAT + b * CTXL + cc * CH; posbase = cc * CH; }
    else { is_lat = true; rowbase = b * SEQ + (cc - NCH_C) * CH; posbase = (cc - NCH_C) * CH; }
}
__device__ __forceinline__ void load_vt(const bf16_t* proj, int rowbase, int h, LAS bf16_t* VT, int tid) {
#pragma unroll
    for (int q = 0; q < 4; ++q) { const int u = tid + q * 512, j = u & 127, e8 = (u >> 7) * 8;
        const u32x4 v = *(const u32x4*)(proj + (size_t)(rowbase + j) * INW + OFF_V + h * DK + e8);
        LAS bf16_t* p = VT + e8 * LDP + j;
        p[0 * LDP] = (bf16_t)(v.x & 0xffff); p[1 * LDP] = (bf16_t)(v.x >> 16); p[2 * LDP] = (bf16_t)(v.y & 0xffff); p[3 * LDP] = (bf16_t)(v.y >> 16);
        p[4 * LDP] = (bf16_t)(v.z & 0xffff); p[5 * LDP] = (bf16_t)(v.z >> 16); p[6 * LDP] = (bf16_t)(v.w & 0xffff); p[7 * LDP] = (bf16_t)(v.w >> 16); }
}

__device__ __forceinline__ void kv_phase(const Args& a, const Frame& F, int l, bool norope = false) {
    bf16_t* proj = (bf16_t*)(a.ws + WS_PROJ); bf16_t* KVT = (bf16_t*)(a.ws + WS_KVT); const float* LG = (const float*)(a.ws + WS_LG) + l * 16;
    LAS bf16_t* KFT = (LAS bf16_t*)F.lds; LAS bf16_t* KBT = KFT + 128 * LDP; LAS bf16_t* VT = KBT + 128 * LDP;
    const int fr = F.lane & 15, fq = F.lane >> 4;
    for (int it = F.bid; it < 32 * NCH; it += F.G) {
        int b, h, cc, rowbase, posbase; bool is_lat; chunk_decode(it, b, h, cc, rowbase, is_lat, posbase);
        if (norope) is_lat = false;
        const float lgf = LG[h], lgb = LG[8 + h];
        u32x4 kx1[2], kx2[2], qx1[2], qx2[2], vreg[4];
#pragma unroll
        for (int q = 0; q < 2; ++q) { const int u = F.tid + q * 512, j = u & 127, sub = u >> 7, base = (sub >> 2) * 64, i0 = (sub & 3) * 8;
            const bf16_t* kp = proj + (size_t)(rowbase + j) * INW + OFF_K + h * DK + base + i0; kx1[q] = *(const u32x4*)kp; kx2[q] = *(const u32x4*)(kp + 32);
            if (is_lat) { const bf16_t* qp = proj + (size_t)(rowbase + j) * INW + OFF_Q + h * DK + base + i0; qx1[q] = *(const u32x4*)qp; qx2[q] = *(const u32x4*)(qp + 32); } }
#pragma unroll
        for (int q = 0; q < 4; ++q) { const int u = F.tid + q * 512, vr = u >> 4, vc = u & 15; vreg[q] = *(const u32x4*)(proj + (size_t)(rowbase + vr) * INW + OFF_V + h * DK + vc * 8); }
#pragma unroll
        for (int q = 0; q < 2; ++q) {
            const int u = F.tid + q * 512, j = u & 127, sub = u >> 7, base = (sub >> 2) * 64, i0 = (sub & 3) * 8;
            const int n = posbase + j; const float pos = (float)(base == 0 ? (n >> 6) : (n & 63));
            float cs[8], sn[8];
#pragma unroll
            for (int e = 0; e < 8; ++e) { const float inv = exp2f(-(float)(i0 + e) * (13.287712379549449f / 32.0f)); float rev = pos * inv * 0.15915494309189535f; rev -= floorf(rev);
                cs[e] = is_lat ? cos_rev(rev) : 1.0f; sn[e] = is_lat ? sin_rev(rev) : 0.0f; }
            bf16_t* kp = proj + (size_t)(rowbase + j) * INW + OFF_K + h * DK + base + i0;
            float x1[8], x2[8], o1[8], o2[8];
            unpack8(kx1[q], x1); unpack8(kx2[q], x2);
#pragma unroll
            for (int e = 0; e < 8; ++e) { o1[e] = x1[e] * cs[e] - x2[e] * sn[e]; o2[e] = x1[e] * sn[e] + x2[e] * cs[e]; }
            if (is_lat) { *(u32x4*)kp = pack8(o1); *(u32x4*)(kp + 32) = pack8(o2); }
            const float wf = __expf(lgf * (float)(CH - 1 - j)), wb = __expf(lgb * (float)j);
#pragma unroll
            for (int e = 0; e < 8; ++e) {
                KFT[(base + i0 + e) * LDP + j] = (bf16_t)f2bf(o1[e] * wf); KFT[(base + 32 + i0 + e) * LDP + j] = (bf16_t)f2bf(o2[e] * wf);
                KBT[(base + i0 + e) * LDP + j] = (bf16_t)f2bf(o1[e] * wb); KBT[(base + 32 + i0 + e) * LDP + j] = (bf16_t)f2bf(o2[e] * wb); }
            if (is_lat) {
                bf16_t* qp = proj + (size_t)(rowbase + j) * INW + OFF_Q + h * DK + base + i0;
                unpack8(qx1[q], x1); unpack8(qx2[q], x2);
#pragma unroll
                for (int e = 0; e < 8; ++e) { o1[e] = x1[e] * cs[e] - x2[e] * sn[e]; o2[e] = x1[e] * sn[e] + x2[e] * cs[e]; }
                *(u32x4*)qp = pack8(o1); *(u32x4*)(qp + 32) = pack8(o2);
            }
        }
#pragma unroll
        for (int q = 0; q < 4; ++q) { const int u = F.tid + q * 512, vr = u >> 4, vc = u & 15; *(LAS u32x4*)((LAS unsigned char*)VT + off_b(vr, vc)) = vreg[q]; }
        __syncthreads();
        const int dt = F.wave;
        bf16x8 aff[4], afb[4];
#pragma unroll
        for (int ks = 0; ks < 4; ++ks) { aff[ks] = *(const LAS bf16x8*)(KFT + (dt * 16 + fr) * LDP + ks * 32 + fq * 8); afb[ks] = *(const LAS bf16x8*)(KBT + (dt * 16 + fr) * LDP + ks * 32 + fq * 8); }
        const unsigned vbase = (unsigned)(unsigned long)VT;
        bf16_t* dstf = KVT + (size_t)it * 2 * 16384; bf16_t* dstb = dstf + 16384;
#pragma unroll
        for (int et = 0; et < 8; ++et) {
            u32x2 r[2][4];
            tr_read8(vbase + tr_addr(8 * fq, et, F.lane), vbase + tr_addr(8 * fq + 4, et, F.lane), r);
            f32x4 accf = (f32x4){0.f, 0.f, 0.f, 0.f}, accb = (f32x4){0.f, 0.f, 0.f, 0.f};
#pragma unroll
            for (int ks = 0; ks < 4; ++ks) { u32x4 bw; bw.x = r[0][ks].x; bw.y = r[0][ks].y; bw.z = r[1][ks].x; bw.w = r[1][ks].y; const bf16x8 bv = as_bf16x8(bw);
                accf = mfma16(aff[ks], bv, accf); accb = mfma16(afb[ks], bv, accb); }
            u32x2 wf; wf.x = pk2(accf[0], accf[1]); wf.y = pk2(accf[2], accf[3]); *(u32x2*)(dstf + (et * 16 + fr) * 128 + dt * 16 + fq * 4) = wf;
            u32x2 wb; wb.x = pk2(accb[0], accb[1]); wb.y = pk2(accb[2], accb[3]); *(u32x2*)(dstb + (et * 16 + fr) * 128 + dt * 16 + fq * 4) = wb;
        }
        __syncthreads();
    }
}

__device__ __forceinline__ void fourier1(const Args& a, const Frame& F, int l) {
    const bf16_t* proj = (const bf16_t*)(a.ws + WS_PROJ); const bf16_t* A1 = (const bf16_t*)(a.ws + WS_A1); bf16_t* TP = (bf16_t*)(a.ws + WS_TP);
    const int fr = F.lane & 15, fq = F.lane >> 4, w = F.wave;
    LAS bf16_t* XS = (LAS bf16_t*)F.lds;
    {
        bf16x8 af[8][2];
#pragma unroll
        for (int t = 0; t < 8; ++t)
#pragma unroll
            for (int ks = 0; ks < 2; ++ks) af[t][ks] = *(const bf16x8*)(A1 + (t * 16 + fr) * 64 + ks * 32 + fq * 8);
        for (int it = F.bid; it < 256; it += F.G) {
            const int cblk = it & 15, nb = (it >> 4) & 3, b = it >> 6;
            u32x4 xr[8];
#pragma unroll
            for (int q = 0; q < 8; ++q) { const int u = F.tid + q * 512, row = u >> 2, ch = u & 3, aa = row >> 4, n2l = row & 15;
                xr[q] = *(const u32x4*)(proj + (size_t)(b * SEQ + 64 * aa + nb * 16 + n2l) * INW + OFF_FX + cblk * 32 + ch * 8); }
#pragma unroll
            for (int q = 0; q < 8; ++q) { const int u = F.tid + q * 512, row = u >> 2, ch = u & 3; *(LAS u32x4*)(XS + row * 40 + ch * 8) = xr[q]; }
            __syncthreads();
            const int n2 = nb * 16 + fr;
            float tcs[4][4], tsn[4][4];
#pragma unroll
            for (int t = 0; t < 4; ++t)
#pragma unroll
                for (int r = 0; r < 4; ++r) { const int m1 = t * 16 + fq * 4 + r; const float rev = (float)((m1 * n2) & 4095) * (1.0f / 4096.0f); tcs[t][r] = cos_rev(rev) * (1.0f / 64.0f); tsn[t][r] = sin_rev(rev) * (1.0f / 64.0f); }
#pragma unroll 1
            for (int cl = 0; cl < 4; ++cl) {
                const int c = w * 4 + cl;
                bf16x8 bfrag[2];
#pragma unroll
                for (int ks = 0; ks < 2; ++ks)
#pragma unroll
                    for (int jj = 0; jj < 8; ++jj) bfrag[ks][jj] = (short)XS[((ks * 32 + fq * 8 + jj) * 16 + fr) * 40 + c];
                f32x4 acc[8];
#pragma unroll
                for (int t = 0; t < 8; ++t) { acc[t] = (f32x4){0.f, 0.f, 0.f, 0.f};
#pragma unroll
                    for (int ks = 0; ks < 2; ++ks) acc[t] = mfma16(af[t][ks], bfrag[ks], acc[t]); }
                const int cg_ = cblk * 32 + c;
#pragma unroll
                for (int t = 0; t < 4; ++t)
#pragma unroll
                    for (int r = 0; r < 4; ++r) { const int m1 = t * 16 + fq * 4 + r; const float tr = acc[t][r], ti = acc[t + 4][r];
                        *(unsigned*)(TP + ((size_t)(b * 64 + m1) * 512 + cg_) * 128 + 2 * n2) = pk2(tr * tcs[t][r] + ti * tsn[t][r], ti * tcs[t][r] - tr * tsn[t][r]); }
            }
            __syncthreads();
        }
    }
    if (l == 0) {
        const int gt = F.bid * 512 + F.tid, NT = F.G * 512;
        for (int o = gt; o < 4 * 4 * 64 * 512; o += NT) {
            const int c = o & 511, n2 = (o >> 9) & 63, m1 = (o >> 15) & 3, b = o >> 17;
            float tr = 0.f, ti = 0.f;
#pragma unroll
            for (int aa = 0; aa < 4; ++aa) { const float x = bf2f(proj[(size_t)(MLAT + b * CTXL + 64 * aa + n2) * INW + OFF_FX + c]); const float rev = (float)((m1 * aa) & 3) * 0.25f;
                tr += x * cos_rev(rev); ti -= x * sin_rev(rev); }
            const float rev = (float)((m1 * n2) & 255) * (1.0f / 256.0f); const float cs = cos_rev(rev), sn = sin_rev(rev);
            const float tr2 = (tr * cs + ti * sn) * (1.0f / 16.0f), ti2 = (ti * cs - tr * sn) * (1.0f / 16.0f);
            *(unsigned*)(TP + TP_CTX_OFF + ((size_t)(b * 4 + m1) * 512 + c) * 128 + 2 * n2) = pk2(tr2, ti2);
        }
    }
}

template <int G>
__device__ __forceinline__ void pool_item(const bf16_t* proj, const LAS bf16_t* WPL, const LAS bf16_t* ROWS, bf16_t* AB, const float* psc, int row0, int t, int N, int tl, int fr, int fq) {
    constexpr int half = 1 << G;
    const int lo = max(t - half, 0), hi = min(t + half, N); const float rc = 1.0f / (float)(hi - lo);
    bf16x8 af[4];
#pragma unroll
    for (int ks = 0; ks < 4; ++ks) {
        const LAS bf16_t* cp = ROWS + (tl - half) * LDP + ks * 32 + fq * 8;
        float s[8], me[8], f[8];
#pragma unroll
        for (int e = 0; e < 8; ++e) s[e] = 0.f;
#pragma unroll
        for (int dd = 0; dd < 2 * half; ++dd) { unpack8(*(const LAS u32x4*)(cp + dd * LDP), f);
#pragma unroll
            for (int e = 0; e < 8; ++e) s[e] += f[e]; }
        unpack8(*(const LAS u32x4*)(cp + half * LDP), me);
#pragma unroll
        for (int e = 0; e < 8; ++e) s[e] = s[e] * rc - me[e];
        af[ks] = as_bf16x8(pack8(s));
    }
    const size_t row = (size_t)(row0 + fr);
#pragma unroll
    for (int dt = 0; dt < 8; ++dt) { f32x4 acc = (f32x4){0.f, 0.f, 0.f, 0.f};
#pragma unroll
        for (int ks = 0; ks < 4; ++ks) { const bf16x8 wv = *(const LAS bf16x8*)(WPL + (dt * 16 + fr) * LDP + ks * 32 + fq * 8); acc = mfma16(wv, af[ks], acc); }
        const int d0 = G * 128 + dt * 16 + fq * 4; const f32x4 ps = *(const f32x4*)(psc + d0); const u32x2 gv = *(const u32x2*)(proj + row * INW + OFF_PG + d0);
        u32x2 o; o.x = pk2(acc[0] * ps[0] * bflo(gv.x), acc[1] * ps[1] * bfhi(gv.x)); o.y = pk2(acc[2] * ps[2] * bflo(gv.y), acc[3] * ps[3] * bfhi(gv.y));
        *(u32x2*)(AB + row * LDX + 512 + d0) = o;
        if (dt & 1) asm volatile("" ::: "memory"); }
}
__device__ __forceinline__ void pool_phase(const Args& a, const Frame& F, int l) {
    const bf16_t* proj = (const bf16_t*)(a.ws + WS_PROJ); const bf16_t* WPT = (const bf16_t*)(a.ws + WS_WPT); bf16_t* AB = (bf16_t*)(a.ws + WS_XN);
    const float* psc = a.pool_scale + (size_t)l * 512;
    const int NGW = F.G * 8, fr = F.lane & 15, fq = F.lane >> 4;
    const int ntb = (l == 0 ? MTOT : MLAT) / 16, nitems = 4 * ntb;
    LAS bf16_t* WPL = (LAS bf16_t*)F.lds;
    LAS bf16_t* ROWS = WPL + 128 * LDP;
    int cur_g = -1;
    for (int it0 = F.bid * 8; it0 < nitems; it0 += NGW) {
        const int g = it0 / ntb, tb0 = it0 - g * ntb, row0b = tb0 * 16;
        int seqbase, N;
        if (row0b < MLAT) { seqbase = row0b & ~(SEQ - 1); N = SEQ; } else { seqbase = MLAT + ((row0b - MLAT) & ~(CTXL - 1)); N = CTXL; }
        const int T0 = row0b - seqbase;
        __syncthreads();
        if (g != cur_g) {
            for (int o = F.tid; o < 128 * 16; o += 512) { const int r = o >> 4, c16 = o & 15; *(LAS u32x4*)(WPL + r * LDP + c16 * 8) = *(const u32x4*)(WPT + (size_t)(g * 128 + r) * 128 + c16 * 8); }
            cur_g = g;
        }
        {
            u32x4 rv[5];
#pragma unroll
            for (int k = 0; k < 5; ++k) { const int u = F.tid + k * 512, r = u >> 4, c16 = u & 15, tt = T0 - 8 + r;
                rv[k] = (u < 144 * 16 && tt >= 0 && tt < N) ? *(const u32x4*)(proj + (size_t)(seqbase + tt) * INW + OFF_PX + g * 128 + c16 * 8) : (u32x4){0u, 0u, 0u, 0u}; }
#pragma unroll
            for (int k = 0; k < 5; ++k) { const int u = F.tid + k * 512, r = u >> 4, c16 = u & 15; if (u < 144 * 16) *(LAS u32x4*)(ROWS + r * LDP + c16 * 8) = rv[k]; }
        }
        __syncthreads();
        const int it = it0 + F.wave;
        if (it >= nitems) continue;
        const int row0 = row0b + F.wave * 16, t = T0 + F.wave * 16 + fr, tl = 8 + F.wave * 16 + fr;
        if (g == 0) pool_item<0>(proj, WPL, ROWS, AB, psc, row0, t, N, tl, fr, fq);
        else if (g == 1) pool_item<1>(proj, WPL, ROWS, AB, psc, row0, t, N, tl, fr, fq);
        else if (g == 2) pool_item<2>(proj, WPL, ROWS, AB, psc, row0, t, N, tl, fr, fq);
        else pool_item<3>(proj, WPL, ROWS, AB, psc, row0, t, N, tl, fr, fq);
    }
    __syncthreads();
}

__device__ __forceinline__ void scan_phase(const Args& a, const Frame& F, int l) {
    const bf16_t* KVT = (const bf16_t*)(a.ws + WS_KVT); bf16_t* SST = (bf16_t*)(a.ws + WS_SST); const float* LG = (const float*)(a.ws + WS_LG) + l * 16;
    const int gt = F.bid * 512 + F.tid, NT = F.G * 512;
    for (int o = gt; o < 32 * 2 * 128 * 16; o += NT) {
        const int d8 = o & 15, e = (o >> 4) & 127, dir = (o >> 11) & 1, bh = o >> 12, h = bh & 7;
        const float dec = __expf(LG[dir * 8 + h] * (float)CH);
        float s[8];
#pragma unroll
        for (int q = 0; q < 8; ++q) s[q] = 0.f;
        for (int st0 = 0; st0 < NCH; st0 += 17) {
            u32x4 kvr[17]; size_t offs[17];
#pragma unroll
            for (int q = 0; q < 17; ++q) { const int st = st0 + q; const int cc = (dir == 0) ? st : ((st < NCH_C) ? (NCH_C - 1 - st) : (NCH - 1 - (st - NCH_C)));
                offs[q] = ((size_t)(bh * NCH + cc) * 2 + dir) * 16384 + e * 128 + d8 * 8; kvr[q] = *(const u32x4*)(KVT + offs[q]); }
#pragma unroll
            for (int q = 0; q < 17; ++q) { *(u32x4*)(SST + offs[q]) = pack8(s); float kv[8]; unpack8(kvr[q], kv);
#pragma unroll
                for (int z = 0; z < 8; ++z) s[z] = dec * s[z] + kv[z]; }
        }
    }
}

__device__ __forceinline__ void fourier2(const Args& a, const Frame& F, int l) {
    const bf16_t* proj = (const bf16_t*)(a.ws + WS_PROJ); const bf16_t* A3 = (const bf16_t*)(a.ws + WS_A3); const bf16_t* TP = (const bf16_t*)(a.ws + WS_TP);
    const bf16_t* WCST = (const bf16_t*)(a.ws + WS_WCST); bf16_t* AB = (bf16_t*)(a.ws + WS_XN);
    const int gw = F.bid * 8 + F.wave, NGW = F.G * 8, fr = F.lane & 15, fq = F.lane >> 4;
    const int nlat = 4 * 64 * 4 * 4, nitems = nlat + (l == 0 ? 4 * 4 * 4 * 4 : 0);
    LAS bf16_t* WCL = (LAS bf16_t*)F.lds;
    LAS bf16_t* TPL = (LAS bf16_t*)(F.lds + 65536);
    int cur_g = -1;
    for (int it0 = F.bid * 8; it0 < nitems; it0 += NGW) {
        const int it = it0 + F.wave;
        const int gblk = (it0 < nlat) ? ((it0 >> 8) & 3) : ((it0 - nlat) >> 6);
        __syncthreads();
        if (gblk != cur_g) {
            for (int o = F.tid; o < 4096; o += 512) *(LAS u32x4*)(WCL + o * 8) = *(const u32x4*)(WCST + (size_t)gblk * 32768 + (size_t)o * 8);
            cur_g = gblk;
        }
        {
            u32x4 tv[8];
#pragma unroll
            for (int k = 0; k < 8; ++k) { const int u = F.tid + k * 512, q = u >> 11, row = (u >> 4) & 127, c16 = u & 15; const int itq = it0 + 4 * q;
                const bf16_t* tq;
                if (itq < nlat) tq = TP + ((size_t)((itq >> 10) * 64 + ((itq >> 2) & 63)) * 512 + ((itq >> 8) & 3) * 128) * 128;
                else { const int i2 = itq - nlat; tq = TP + TP_CTX_OFF + ((size_t)(((i2 >> 4) & 3) * 4 + ((i2 >> 2) & 3)) * 512 + (i2 >> 6) * 128) * 128; }
                tv[k] = (itq < nitems) ? *(const u32x4*)(tq + (size_t)row * 128 + c16 * 8) : (u32x4){0u, 0u, 0u, 0u}; }
#pragma unroll
            for (int k = 0; k < 8; ++k) { const int u = F.tid + k * 512, q = u >> 11, row = (u >> 4) & 127, c16 = u & 15; *(LAS u32x4*)(TPL + (q * 128 + row) * LDP + c16 * 8) = tv[k]; }
        }
        __syncthreads();
        if (it >= nitems) continue;
        int mb, g, m1, s, NM1, seqbase;
        if (it < nlat) { mb = it & 3; m1 = (it >> 2) & 63; g = (it >> 8) & 3; s = it >> 10; NM1 = 64; seqbase = s * SEQ; }
        else { const int i2 = it - nlat; mb = i2 & 3; m1 = (i2 >> 2) & 3; s = (i2 >> 4) & 3; g = i2 >> 6; NM1 = 4; seqbase = MLAT + s * CTXL; }
        const LAS bf16_t* tpl = TPL + (F.wave >> 2) * 128 * LDP;
        f32x4 accY[8][2];
#pragma unroll
        for (int cbk = 0; cbk < 8; ++cbk) { accY[cbk][0] = (f32x4){0.f, 0.f, 0.f, 0.f}; accY[cbk][1] = (f32x4){0.f, 0.f, 0.f, 0.f}; }
#pragma unroll
        for (int ks = 0; ks < 4; ++ks) {
            const bf16x8 b0 = *(const bf16x8*)(A3 + (mb * 16 + fr) * 128 + ks * 32 + fq * 8), b1 = *(const bf16x8*)(A3 + (64 + mb * 16 + fr) * 128 + ks * 32 + fq * 8);
#pragma unroll
            for (int cbk = 0; cbk < 8; ++cbk) { const bf16x8 av = *(const LAS bf16x8*)(tpl + (cbk * 16 + fr) * LDP + ks * 32 + fq * 8);
                accY[cbk][0] = mfma16(av, b0, accY[cbk][0]); accY[cbk][1] = mfma16(av, b1, accY[cbk][1]); }
        }
        f32x4 acc2[8];
#pragma unroll
        for (int dt = 0; dt < 8; ++dt) acc2[dt] = (f32x4){0.f, 0.f, 0.f, 0.f};
#pragma unroll
        for (int cbk = 0; cbk < 8; ++cbk) {
            u32x4 w; w.x = pk2(accY[cbk][0][0], accY[cbk][0][1]); w.y = pk2(accY[cbk][0][2], accY[cbk][0][3]); w.z = pk2(accY[cbk][1][0], accY[cbk][1][1]); w.w = pk2(accY[cbk][1][2], accY[cbk][1][3]);
            const bf16x8 f2 = as_bf16x8(w);
#pragma unroll
            for (int dt = 0; dt < 8; ++dt) { const bf16x8 wv = *(const LAS bf16x8*)(WCL + ((cbk * 128 + dt * 16 + fr) * 4 + fq) * 8); acc2[dt] = mfma16(wv, f2, acc2[dt]); }
        }
        const size_t row = (size_t)(seqbase + m1 + NM1 * (mb * 16 + fr));
        u32x2 gv[8];
#pragma unroll
        for (int dt = 0; dt < 8; ++dt) gv[dt] = *(const u32x2*)(proj + row * INW + OFF_FG + g * 128 + dt * 16 + fq * 4);
#pragma unroll
        for (int dt = 0; dt < 8; ++dt) { u32x2 o; o.x = pk2(acc2[dt][0] * bflo(gv[dt].x), acc2[dt][1] * bfhi(gv[dt].x)); o.y = pk2(acc2[dt][2] * bflo(gv[dt].y), acc2[dt][3] * bfhi(gv[dt].y));
            *(u32x2*)(AB + row * LDX + g * 128 + dt * 16 + fq * 4) = o; }
        asm volatile("" ::: "memory");
    }
    __syncthreads();
}

__device__ __forceinline__ bf16x8 scale_frag(bf16x8 q, float s) {
    const u32x4 v = __builtin_bit_cast(u32x4, q); float f[8]; unpack8(v, f);
#pragma unroll
    for (int e = 0; e < 8; ++e) f[e] *= s;
    return as_bf16x8(pack8(f));
}
__device__ __forceinline__ void retout_phase(const Args& a, const Frame& F, int l, int mode, int skipwg) {
    const bf16_t* KVT = (const bf16_t*)(a.ws + WS_KVT);
    const bf16_t* proj = (const bf16_t*)(a.ws + WS_PROJ); const bf16_t* SST = (const bf16_t*)(a.ws + WS_SST); bf16_t* AB = (bf16_t*)(a.ws + WS_XN);
    const float* LG = (const float*)(a.ws + WS_LG) + l * 16;
    LAS bf16_t* KS = (LAS bf16_t*)F.lds; LAS bf16_t* VT = KS + 128 * LDP; LAS bf16_t* SF = VT + 128 * LDP; LAS bf16_t* SB = SF + 128 * LDP;
    const int fr = F.lane & 15, fq = F.lane >> 4, w = F.wave;
    const int widx = (mode == 2) ? F.bid - skipwg : F.bid, nwk = (mode == 2) ? F.G - skipwg : F.G, nv = (mode == 1) ? 32 * NCH_C : 32 * NCH_L;
    if (widx < 0) return;
    for (int v = widx; v < nv; v += nwk) {
        const int it = (mode == 1) ? ((v >> 1) * NCH + (v & 1)) : ((v >> 5) * NCH + NCH_C + (v & 31));
        int b, h, cc, rowbase, posbase; bool is_lat; chunk_decode(it, b, h, cc, rowbase, is_lat, posbase);
        const float lgf = LG[h], lgb = LG[8 + h];
        const int i = w * 16 + fr;
        {
            u32x4 kreg[4], sfreg[4], sbreg[4], vreg[4];
            const bf16_t* stf = SST + (size_t)it * 2 * 16384; const bf16_t* stb = stf + 16384; bool zf = false, zb = false;
            if (mode == 1) { stf = KVT + (size_t)(it - 1) * 2 * 16384; stb = KVT + (size_t)(it + 1) * 2 * 16384 + 16384; zf = (cc == 0); zb = (cc == 1); }
            const u32x4 zero4 = {0u, 0u, 0u, 0u};
#pragma unroll
            for (int q = 0; q < 4; ++q) { const int u = F.tid + q * 512, row = u >> 4, c16 = u & 15;
                kreg[q] = *(const u32x4*)(proj + (size_t)(rowbase + row) * INW + OFF_K + h * DK + c16 * 8);
                sfreg[q] = zf ? zero4 : *(const u32x4*)(stf + row * 128 + c16 * 8); sbreg[q] = zb ? zero4 : *(const u32x4*)(stb + row * 128 + c16 * 8); }
#pragma unroll
            for (int q = 0; q < 4; ++q) { const int u = F.tid + q * 512, j = u & 127, e8 = (u >> 7) * 8;
                vreg[q] = *(const u32x4*)(proj + (size_t)(rowbase + j) * INW + OFF_V + h * DK + e8); }
#pragma unroll
            for (int q = 0; q < 4; ++q) { const int u = F.tid + q * 512, row = u >> 4, c16 = u & 15;
                *(LAS u32x4*)(KS + row * LDP + c16 * 8) = kreg[q]; *(LAS u32x4*)(SF + row * LDP + c16 * 8) = sfreg[q]; *(LAS u32x4*)(SB + row * LDP + c16 * 8) = sbreg[q]; }
#pragma unroll
            for (int q = 0; q < 4; ++q) { const int u = F.tid + q * 512, j = u & 127, e8 = (u >> 7) * 8; const u32x4 v = vreg[q];
                LAS bf16_t* p = VT + e8 * LDP + j;
                p[0 * LDP] = (bf16_t)(v.x & 0xffff); p[1 * LDP] = (bf16_t)(v.x >> 16); p[2 * LDP] = (bf16_t)(v.y & 0xffff); p[3 * LDP] = (bf16_t)(v.y >> 16);
                p[4 * LDP] = (bf16_t)(v.z & 0xffff); p[5 * LDP] = (bf16_t)(v.z >> 16); p[6 * LDP] = (bf16_t)(v.w & 0xffff); p[7 * LDP] = (bf16_t)(v.w >> 16); }
        }
        bf16x8 qf[4];
#pragma unroll
        for (int ks = 0; ks < 4; ++ks) qf[ks] = *(const bf16x8*)(proj + (size_t)(rowbase + i) * INW + OFF_Q + h * DK + ks * 32 + fq * 8);
        __syncthreads();
        f32x4 accS[8];
#pragma unroll
        for (int jt = 0; jt < 8; ++jt) { accS[jt] = (f32x4){0.f, 0.f, 0.f, 0.f};
#pragma unroll
            for (int ks = 0; ks < 4; ++ks) { const bf16x8 kf = *(const LAS bf16x8*)(KS + (jt * 16 + fr) * LDP + ks * 32 + fq * 8); accS[jt] = mfma16(kf, qf[ks], accS[jt]); }
            if (jt & 1) asm volatile("" ::: "memory"); }
        const float l2f = lgf * 1.4426950408889634f, l2b = lgb * 1.4426950408889634f;
#pragma unroll
        for (int jt = 0; jt < 8; ++jt)
#pragma unroll
            for (int r = 0; r < 4; ++r) { const int j = jt * 16 + fq * 4 + r, dl = i - j;
                const float dv = dl > 0 ? exp2f((float)dl * l2f) : (dl < 0 ? exp2f((float)(-dl) * l2b) : 2.0f); accS[jt][r] *= dv; }
        f32x4 accO[8];
#pragma unroll
        for (int et = 0; et < 8; ++et) accO[et] = (f32x4){0.f, 0.f, 0.f, 0.f};
#pragma unroll
        for (int kb = 0; kb < 4; ++kb) {
            u32x4 pw; pw.x = pk2(accS[2 * kb][0], accS[2 * kb][1]); pw.y = pk2(accS[2 * kb][2], accS[2 * kb][3]); pw.z = pk2(accS[2 * kb + 1][0], accS[2 * kb + 1][1]); pw.w = pk2(accS[2 * kb + 1][2], accS[2 * kb + 1][3]);
            const bf16x8 pf = as_bf16x8(pw);
#pragma unroll
            for (int et = 0; et < 8; ++et) { const LAS bf16_t* vp = VT + (et * 16 + fr) * LDP + kb * 32 + fq * 4;
                const u32x2 lo = *(const LAS u32x2*)vp, hi = *(const LAS u32x2*)(vp + 16);
                u32x4 vv; vv.x = lo.x; vv.y = lo.y; vv.z = hi.x; vv.w = hi.y;
                accO[et] = mfma16(as_bf16x8(vv), pf, accO[et]); }
            asm volatile("" ::: "memory");
        }
        const float sf = __expf(lgf * (float)(i + 1)), sb = __expf(lgb * (float)(CH - i));
#pragma unroll
        for (int dir = 0; dir < 2; ++dir) {
            const LAS bf16_t* st = dir ? SB : SF;
#pragma unroll
            for (int ks = 0; ks < 4; ++ks) { const bf16x8 qs = scale_frag(qf[ks], dir ? sb : sf);
#pragma unroll
                for (int et = 0; et < 8; ++et) { const bf16x8 sv = *(const LAS bf16x8*)(st + (et * 16 + fr) * LDP + ks * 32 + fq * 8); accO[et] = mfma16(sv, qs, accO[et]); }
                asm volatile("" ::: "memory"); }
        }
        float ss = 0.f;
#pragma unroll
        for (int et = 0; et < 8; ++et) ss += (accO[et][0] * accO[et][0] + accO[et][1] * accO[et][1]) + (accO[et][2] * accO[et][2] + accO[et][3] * accO[et][3]);
        ss += __shfl_xor(ss, 16); ss += __shfl_xor(ss, 32);
        const float rinv = 1.0f / sqrtf(ss * (1.0f / 128.0f) + EPS);
        const size_t row = (size_t)(rowbase + i);
        u32x2 gv[8];
#pragma unroll
        for (int et = 0; et < 8; ++et) gv[et] = *(const u32x2*)(proj + row * INW + OFF_RG + h * DK + et * 16 + fq * 4);
#pragma unroll
        for (int et = 0; et < 8; ++et) { const int e = h * DK + et * 16 + fq * 4;
            u32x2 o; o.x = pk2(accO[et][0] * rinv * bflo(gv[et].x), accO[et][1] * rinv * bfhi(gv[et].x)); o.y = pk2(accO[et][2] * rinv * bflo(gv[et].y), accO[et][3] * rinv * bfhi(gv[et].y));
            *(u32x2*)(AB + row * LDX + 1024 + e) = o; }
        __syncthreads();
    }
}

__device__ __forceinline__ void final_norm(const Args& a, const Frame& F) {
    const int gw = F.bid * 8 + F.wave, NGW = F.G * 8;
    const bf16_t* xb = (const bf16_t*)(a.ws + WS_XFIN);
    u32x4 nx[4];
    if (gw < MLAT) {
#pragma unroll
        for (int j = 0; j < 4; ++j) nx[j] = *(const u32x4*)(xb + (size_t)gw * D + (j * 64 + F.lane) * 8); }
    for (int m = gw; m < MLAT; m += NGW) {
        float v[4][8]; float s = 0.f;
#pragma unroll
        for (int j = 0; j < 4; ++j) { unpack8(nx[j], v[j]);
#pragma unroll
            for (int e = 0; e < 8; ++e) s += v[j][e] * v[j][e]; }
        const int m2 = m + NGW;
        if (m2 < MLAT) {
#pragma unroll
            for (int j = 0; j < 4; ++j) nx[j] = *(const u32x4*)(xb + (size_t)m2 * D + (j * 64 + F.lane) * 8); }
#pragma unroll
        for (int o = 1; o < 64; o <<= 1) s += __shfl_xor(s, o);
        const float r = 1.0f / sqrtf(s * (1.0f / D) + EPS);
#pragma unroll
        for (int j = 0; j < 4; ++j) { const int col = (j * 64 + F.lane) * 8;
#pragma unroll
            for (int hh = 0; hh < 2; ++hh) { const f32x4 g = *(const f32x4*)(a.final_g + col + 4 * hh); f32x4 o;
#pragma unroll
                for (int e = 0; e < 4; ++e) o[e] = (v[j][4 * hh + e] * r) * g[e];
                *(f32x4*)(a.out + (size_t)m * D + col + 4 * hh) = o; } }
    }
}

#define XB_TMO      128
#define XB_XCNT(j)  (256  + 64 * (j))
#define XB_XSUB(j)  (1280 + 64 * (j))
#define XB_XGEN(j)  (2304 + 64 * (j))
#define XB_TOP      3328
#define XB_TOPGEN   3392
#define XCD_BAR_WORDS 3456
#define XB_SPIN_CAP (1u << 18)
__device__ __forceinline__ unsigned xb_ld(unsigned* p)              { return __hip_atomic_load(p, __ATOMIC_RELAXED, __HIP_MEMORY_SCOPE_AGENT); }
__device__ __forceinline__ unsigned xb_add(unsigned* p, unsigned v) { return __hip_atomic_fetch_add(p, v, __ATOMIC_RELAXED, __HIP_MEMORY_SCOPE_AGENT); }
__device__ __forceinline__ unsigned xb_xcc_id() { return (unsigned)__builtin_amdgcn_s_getreg((3 << 11) | 20) & 0xFu; }
#define XB_SPIN(cond, bar) do { unsigned _sp = 0; while (cond) { __builtin_amdgcn_s_sleep(1); \
    if ((++_sp & 255u) == 0u) { if (xb_ld(&(bar)[XB_TMO])) break; if (_sp > XB_SPIN_CAP) { atomicAdd(&(bar)[XB_TMO], 1u); break; } } } } while (0)
struct XcdBarrier { unsigned* bar; unsigned x; volatile LAS unsigned* st; };
__device__ __forceinline__ XcdBarrier xcd_barrier_post(unsigned* bar, volatile LAS unsigned* st) {
    XcdBarrier b; b.bar = bar; b.x = xb_xcc_id(); b.st = st;
    if (threadIdx.x == 0) (void)xb_add(&bar[XB_XCNT(b.x)], 1u);
    return b;
}
__device__ __forceinline__ void xcd_barrier_complete(unsigned* bar, unsigned x, unsigned& nloc, unsigned& nx) {
    const unsigned G = gridDim.x * gridDim.y * gridDim.z;
    unsigned sum, cnt, mine, sp = 0u;
    for (;;) {
        sum = 0u; cnt = 0u; mine = 0u;
#pragma unroll
        for (unsigned j = 0; j < 16; ++j) { const unsigned c = xb_ld(&bar[XB_XCNT(j)]); sum += c; cnt += (c > 0u) ? 1u : 0u; mine = (j == x) ? c : mine; }
        if (sum == G) break;
        __builtin_amdgcn_s_sleep(1);
        if ((++sp & 255u) == 0u) { if (xb_ld(&bar[XB_TMO])) break; if (sp > XB_SPIN_CAP) { atomicAdd(&bar[XB_TMO], 1u); break; } }
    }
    nloc = mine > 0u ? mine : 1u; nx = cnt > 0u ? cnt : 1u;
}
__device__ __forceinline__ void xcd_barrier(unsigned* bar_, volatile LAS unsigned* st_) {
    XcdBarrier b; b.bar = bar_; b.st = st_; b.x = xb_xcc_id();
    asm volatile("s_waitcnt vmcnt(0)" ::: "memory");
    __syncthreads();
    if (threadIdx.x == 0) {
        unsigned* bar = b.bar;
        __builtin_amdgcn_s_waitcnt(0);
        unsigned nloc = b.st[0], nx = b.st[1];
        if (nloc == 0u) { xcd_barrier_complete(bar, b.x, nloc, nx); b.st[0] = nloc; b.st[1] = nx; }
        const unsigned old = xb_add(&bar[XB_XSUB(b.x)], 1u);
        const unsigned gen = old / nloc;
        if (old + 1u == (gen + 1u) * nloc) {
            __builtin_amdgcn_fence(__ATOMIC_RELEASE, "agent");
            asm volatile("s_waitcnt vmcnt(0)" ::: "memory");
            const unsigned og = xb_add(&bar[XB_TOP], 1u);
            const unsigned tg = og / nx;
            if (og + 1u == (tg + 1u) * nx) xb_add(&bar[XB_TOPGEN], 1u);
            else XB_SPIN(xb_ld(&bar[XB_TOPGEN]) == tg, bar);
            __builtin_amdgcn_fence(__ATOMIC_ACQUIRE, "agent");
            xb_add(&bar[XB_XGEN(b.x)], 1u);
            asm volatile("s_waitcnt vmcnt(0)" ::: "memory");
        } else {
            XB_SPIN(xb_ld(&bar[XB_XGEN(b.x)]) == gen, bar);
            __builtin_amdgcn_fence(__ATOMIC_ACQUIRE, "agent");
            asm volatile("s_waitcnt vmcnt(0)" ::: "memory");
        }
    }
    __syncthreads();
}

constexpr int NPHASE = 16;
__global__ void __launch_bounds__(512, 2) fwd_mega(const float* p_x, const float* p_c, const float* p_ctx, const float* p_cctx, const float* p_wada, const float* p_bada, const float* p_ng,
        const float* p_win, const float* p_wf, const float* p_wp, const float* p_ps, const float* p_dl, const float* p_wuf, const float* p_wup, const float* p_wur, const float* p_wout,
        const float* p_fg, float* p_out, unsigned char* p_ws, int ph_lo, int ph_hi) {
    Args a{p_x, p_c, p_ctx, p_cctx, p_wada, p_bada, p_ng, p_win, p_wf, p_wp, p_ps, p_dl, p_wuf, p_wup, p_wur, p_wout, p_fg, p_out, p_ws, ph_lo, ph_hi};
    extern __shared__ __attribute__((aligned(16))) unsigned char lds_raw[];
    cg::grid_group grid = cg::this_grid();
    Frame F; F.lds = (LAS unsigned char*)lds_raw; F.tid = threadIdx.x; F.lane = F.tid & 63; F.wave = __builtin_amdgcn_readfirstlane(F.tid >> 6); F.G = gridDim.x; F.bid = blockIdx.x;
#define REFRAME() do { int _t = threadIdx.x; asm volatile("" : "+v"(_t)); { unsigned long long _z = 0; asm volatile("" : "+s"(_z)); a.ws = p_ws + _z; } F.tid = _t; F.lane = _t & 63; F.wave = __builtin_amdgcn_readfirstlane(_t >> 6); } while (0)
    const int lo = a.ph_lo, hi = a.ph_hi;
    volatile LAS unsigned* xst = (volatile LAS unsigned*)(F.lds + LDS_BYTES - 64);
    if (F.tid < 4) xst[F.tid] = 0u;
    __syncthreads();
    (void)xcd_barrier_post((unsigned*)(a.ws + WS_BAR), xst);
#define IN(k) (lo <= (k) && (k) < hi)
#define SEAM(k) do { if (IN(k) && IN((k) + 1)) { if (lo < 0) grid.sync(); else xcd_barrier((unsigned*)(a.ws + WS_BAR), (volatile LAS unsigned*)(F.lds + LDS_BYTES - 64)); } } while (0)
    if (IN(0)) {
#ifndef NO_P0
        p0_mod(a, F); REFRAME(); p0_misc(a, F); REFRAME(); weights_layer(a, F, 0, 31, F.bid, F.G);
#endif
    }
    SEAM(0);
    for (int l = 0; l < DEPTH; ++l) {
        const int p = 1 + 7 * l;
        if (IN(p)) {
#ifndef NO_PA
            REFRAME(); if (l == 0) prenorm(a, F, l, 0); else { prenorm_b16(a, F, l); REFRAME(); prenorm(a, F, l, MLAT); } if (l == 1) { __syncthreads(); REFRAME(); weights_layer(a, F, 1, 31, F.bid, F.G); }
#endif
        }
        SEAM(p);
        if (IN(p + 1)) {
#ifndef NO_PB
            pg8::Gemm g{(const bf16_t*)(a.ws + WS_XN), (const bf16_t*)(a.ws + WS_WIN), LDX, LDX, MTOT, INW, D};
            pg8::StaticOrder S;
            if (l == DEPTH - 1) { S.init(MLAT, INW, F.G, F.bid, WGM_IN); S.add_extra(MLAT / 256, OFF_K / 256, (MCTX / 256) * ((OFF_RG - OFF_K) / 256)); }
            else S.init(MTOT, INW, F.G, F.bid, WGM_IN);
            pg8::EpiInProj E{(bf16_t*)(a.ws + WS_PROJ)};
            pg8::gemm_phase<pg8::EpiInProj>(F.lds, g, S, E);
#endif
        }
        SEAM(p + 1);
        if (IN(p + 2)) {
#ifndef NO_KV
            REFRAME(); kv_phase(a, F, l);
#endif
#ifndef NO_F1
            REFRAME(); fourier1(a, F, l);
#endif
#ifndef NO_POOL
            REFRAME(); pool_phase(a, F, l);
#endif
        }
        SEAM(p + 2);
        if (IN(p + 3)) {
#ifndef NO_SCAN
            REFRAME(); scan_phase(a, F, l);
#endif
#ifndef NO_F2
            REFRAME(); fourier2(a, F, l);
#endif
#ifndef NO_RO
            if (l == 0) { REFRAME(); retout_phase(a, F, l, 1, 0); }
#endif
        }
        SEAM(p + 3);
        constexpr int NCTXU = (MCTX / 256) * (D / 256);
        const bool split = (l == 0) && (F.G >= 4 * NCTXU);
        if (IN(p + 4)) {
#ifndef NO_RO
            if (split && F.bid < NCTXU) {
                pg8::Gemm g{(const bf16_t*)(a.ws + WS_XN) + (size_t)MLAT * LDX, (const bf16_t*)(a.ws + WS_WUP), LDX, LDX, MCTX, D, D};
                pg8::StaticOrder S; S.init(MCTX, D, NCTXU, F.bid, 4);
                pg8::EpiUp E{(const bf16_t*)(a.ws + WS_PROJ) + (size_t)MLAT * INW, (bf16_t*)(a.ws + WS_MERGED) + (size_t)MLAT * LDX};
                pg8::gemm_phase<pg8::EpiUp>(F.lds, g, S, E);
            } else { REFRAME(); retout_phase(a, F, l, split ? 2 : 0, NCTXU); }
#endif
        }
        SEAM(p + 4);
        const int Mrows = (l == 0) ? MTOT : MLAT;
        if (IN(p + 5)) {
#ifndef NO_PF
            const int Mup = split ? MLAT : Mrows;
            pg8::Gemm g{(const bf16_t*)(a.ws + WS_XN), (const bf16_t*)(a.ws + WS_WUP), LDX, LDX, Mup, D, D};
            pg8::StaticOrder S; S.init(Mup, D, F.G, F.bid, WGM_UP);
            pg8::EpiUp E{(const bf16_t*)(a.ws + WS_PROJ), (bf16_t*)(a.ws + WS_MERGED)};
            pg8::gemm_phase<pg8::EpiUp>(F.lds, g, S, E);
#endif
        }
        SEAM(p + 5);
        if (IN(p + 6)) {
#ifndef NO_PG
            pg8::Gemm g{(const bf16_t*)(a.ws + WS_MERGED), (const bf16_t*)(a.ws + WS_WOUT), LDX, LDX, Mrows, D, D};
            pg8::StaticOrder S; S.init(Mrows, D, F.G, F.bid, WGM_OUT);
            pg8::EpiOut E{(l == 0) ? a.x : nullptr, (l == 0) ? nullptr : (const bf16_t*)a.out, (l == DEPTH - 1) ? (bf16_t*)(a.ws + WS_XFIN) : (bf16_t*)a.out, a.ctx, (float*)(a.ws + WS_CTX1),
                          (const float*)(a.ws + WS_MOD) + (size_t)l * 5 * 6144};
            pg8::gemm_phase<pg8::EpiOut>(F.lds, g, S, E);
#endif
        }
        SEAM(p + 6);
    }
    if (IN(15)) { REFRAME(); final_norm(a, F); }
#undef IN
#undef SEAM
}

extern "C" void kernel_launch(void* const* d_in, const int* in_sizes, int n_in, void* d_out, int out_size, void* d_ws, size_t ws_size, hipStream_t stream) {
    static int grid = 0;
    if (grid == 0) {
        if (n_in != 17 || out_size != MLAT * D || ws_size < WS_END) { fprintf(stderr, "kernel_launch: unexpected shapes: n_in %d out %d ws %zu (need >= %zu)\n", n_in, out_size, ws_size, (size_t)WS_END); grid = -1; return; }
        int dev = 0, cus = 0, per_cu = 0;
        if (hipGetDevice(&dev) != hipSuccess || hipDeviceGetAttribute(&cus, hipDeviceAttributeMultiprocessorCount, dev) != hipSuccess) { grid = -1; return; }
        if (hipFuncSetAttribute((const void*)fwd_mega, hipFuncAttributeMaxDynamicSharedMemorySize, LDS_BYTES) != hipSuccess) { fprintf(stderr, "kernel_launch: hipFuncSetAttribute failed\n"); grid = -1; return; }
        if (hipOccupancyMaxActiveBlocksPerMultiprocessor(&per_cu, (const void*)fwd_mega, 512, LDS_BYTES) != hipSuccess || per_cu < 1) { fprintf(stderr, "kernel_launch: occupancy query gave %d\n", per_cu); (void)hipGetLastError(); grid = -1; return; }
        grid = cus * per_cu;
        fprintf(stderr, "kernel_launch: grid %d (cus %d x %d)\n", grid, cus, per_cu);
    }
    if (grid < 0) return;
    Args a{};
    a.x = (const float*)d_in[0]; a.c = (const float*)d_in[1]; a.ctx = (const float*)d_in[2]; a.c_ctx = (const float*)d_in[3]; a.w_ada = (const float*)d_in[4]; a.b_ada = (const float*)d_in[5];
    a.norm_g = (const float*)d_in[6]; a.w_in = (const float*)d_in[7]; a.w_fourier = (const float*)d_in[8]; a.w_pool = (const float*)d_in[9]; a.pool_scale = (const float*)d_in[10];
    a.decay_logit = (const float*)d_in[11]; a.w_up_f = (const float*)d_in[12]; a.w_up_p = (const float*)d_in[13]; a.w_up_r = (const float*)d_in[14]; a.w_out = (const float*)d_in[15];
    a.final_g = (const float*)d_in[16]; a.out = (float*)d_out; a.ws = (unsigned char*)d_ws;
    a.ph_lo = 0; a.ph_hi = NPHASE;
    if (hipMemsetAsync((unsigned char*)d_ws + WS_BAR, 0, XCD_BAR_WORDS * 4, stream) != hipSuccess) { fprintf(stderr, "kernel_launch: memset failed\n"); return; }
    void* args[] = {&a.x, &a.c, &a.ctx, &a.c_ctx, &a.w_ada, &a.b_ada, &a.norm_g, &a.w_in, &a.w_fourier, &a.w_pool, &a.pool_scale, &a.decay_logit, &a.w_up_f, &a.w_up_p, &a.w_up_r, &a.w_out,
                    &a.final_g, &a.out, &a.ws, &a.ph_lo, &a.ph_hi};
    hipError_t e = hipLaunchCooperativeKernel((const void*)fwd_mega, dim3(grid), dim3(512), args, LDS_BYTES, stream);
    if (e != hipSuccess) fprintf(stderr, "kernel_launch: cooperative launch failed: %s (grid %d)\n", hipGetErrorString(e), grid);
}
```

```cpp
#include <hip/hip_runtime.h>
#include <hip/hip_cooperative_groups.h>
#include <cstdio>
#include <cstdint>
namespace cg = cooperative_groups;

#define LAS __attribute__((address_space(3)))
typedef unsigned short bf16_t;
typedef short bf16x8 __attribute__((ext_vector_type(8)));
typedef float f32x4 __attribute__((ext_vector_type(4)));
typedef float f32x2 __attribute__((ext_vector_type(2)));
typedef unsigned u32x4 __attribute__((ext_vector_type(4)));
typedef unsigned u32x2 __attribute__((ext_vector_type(2)));

constexpr int D = 2048, NB = 4, SEQ = 4096, CTXL = 256, DEPTH = 2;
constexpr int MLAT = NB * SEQ, MCTX = NB * CTXL, MTOT = MLAT + MCTX;
constexpr int INW = 12288;
constexpr int LDX = 2048 + 64;
constexpr int OFF_FX = 0, OFF_FG = 512, OFF_PX = 1024, OFF_PG = 1536, OFF_Q = 2048, OFF_K = 3072, OFF_V = 4096, OFF_RG = 5120, OFF_MG = 6144;
constexpr int NH = 8, DK = 128, CH = 128;
constexpr int NCH_L = SEQ / CH, NCH_C = CTXL / CH, NCH = NCH_L + NCH_C;
constexpr float EPS = 1e-6f;
constexpr float TWO_PI = 6.283185307179586f;

constexpr size_t MiB = 1u << 20;
constexpr size_t WS_MOD = 0;
constexpr size_t WS_LG = 248 * 1024;
constexpr size_t WS_WCST = 256 * 1024;
constexpr size_t WS_WPT = 512 * 1024;
constexpr size_t WS_A1 = 640 * 1024;
constexpr size_t WS_A3 = 656 * 1024;
constexpr size_t WS_BAR = 704 * 1024;
constexpr size_t WS_WIN = 1 * MiB;
constexpr size_t WS_WUP = 51 * MiB;
constexpr size_t WS_WOUT = 60 * MiB;
constexpr size_t WS_XN = 69 * MiB;
constexpr size_t WS_PROJ = 140 * MiB;
constexpr size_t WS_XFIN = WS_PROJ;
constexpr size_t WS_CTX1 = 548 * MiB;
constexpr size_t WS_KVT = 556 * MiB;
constexpr size_t WS_MERGED = WS_KVT;
constexpr size_t WS_SST = 627 * MiB;
constexpr size_t WS_TP = 695 * MiB;
constexpr size_t WS_END = 730 * MiB;
static_assert(WS_WIN + (size_t)12288 * LDX * 2 <= WS_WUP && WS_WUP + (size_t)2048 * LDX * 2 <= WS_WOUT && WS_WOUT + (size_t)2048 * LDX * 2 <= WS_XN && WS_XN + (size_t)MTOT * LDX * 2 <= WS_PROJ
              && WS_PROJ + (size_t)MTOT * INW * 2 <= WS_CTX1 && WS_MERGED + (size_t)MTOT * LDX * 2 <= WS_SST && WS_KVT + (size_t)32 * 34 * 2 * 16384 * 2 <= WS_SST && WS_SST + (size_t)32 * 34 * 2 * 16384 * 2 <= WS_TP
              && WS_TP + ((size_t)4 * 64 * 512 * 128 + (size_t)4 * 4 * 512 * 128) * 2 <= WS_END, "d_ws map");
constexpr size_t TP_CTX_OFF = (size_t)4 * 64 * 512 * 128;

constexpr int LDS_BYTES = 147456;
constexpr int WGM_IN = 4, WGM_UP = 4, WGM_OUT = 4;

__device__ __forceinline__ unsigned f2bf(float f) { unsigned u = __float_as_uint(f); return (u + 0x7fffu + ((u >> 16) & 1u)) >> 16; }
__device__ __forceinline__ unsigned pk2(float lo, float hi) { return f2bf(lo) | (f2bf(hi) << 16); }
__device__ __forceinline__ float bflo(unsigned w) { return __uint_as_float(w << 16); }
__device__ __forceinline__ float bfhi(unsigned w) { return __uint_as_float(w & 0xffff0000u); }
__device__ __forceinline__ float bf2f(bf16_t b) { return __uint_as_float(((unsigned)b) << 16); }
__device__ __forceinline__ unsigned cvt_pk_bf16(float lo, float hi) { unsigned r; asm volatile("v_cvt_pk_bf16_f32 %0, %1, %2" : "=v"(r) : "v"(lo), "v"(hi)); return r; }
__device__ __forceinline__ float sigmoidf_(float x) { return __builtin_amdgcn_rcpf(1.0f + __expf(-x)); }
__device__ __forceinline__ f32x4 mfma16(bf16x8 a, bf16x8 b, f32x4 c) { return __builtin_amdgcn_mfma_f32_16x16x32_bf16(a, b, c, 0, 0, 0); }
__device__ __forceinline__ bf16x8 as_bf16x8(u32x4 v) { return __builtin_bit_cast(bf16x8, v); }
__device__ __forceinline__ float sin_rev(float r) { return __builtin_amdgcn_sinf(r); }
__device__ __forceinline__ float cos_rev(float r) { return __builtin_amdgcn_cosf(r); }
#define LDS_WAIT() asm volatile("s_waitcnt lgkmcnt(0)" ::: "memory")
__device__ __forceinline__ void unpack8(const u32x4 v, float (&f)[8]) {
    f[0] = bflo(v.x); f[1] = bfhi(v.x); f[2] = bflo(v.y); f[3] = bfhi(v.y); f[4] = bflo(v.z); f[5] = bfhi(v.z); f[6] = bflo(v.w); f[7] = bfhi(v.w);
}
__device__ __forceinline__ u32x4 pack8(const float (&f)[8]) { u32x4 w; w.x = pk2(f[0], f[1]); w.y = pk2(f[2], f[3]); w.z = pk2(f[4], f[5]); w.w = pk2(f[6], f[7]); return w; }
__device__ __forceinline__ unsigned off_b(unsigned row, unsigned ch) { return 256u * row + 16u * (ch ^ (((row & 3) << 2) | ((row >> 2) & 3))); }
__device__ __forceinline__ unsigned tr_addr(unsigned base_row, unsigned c, unsigned lane) { const unsigned q = (lane & 15) >> 2, p = lane & 3; return off_b(base_row + q, 2 * c + (p >> 1)) + 8 * (p & 1); }
__device__ __forceinline__ void tr_read8(unsigned a0, unsigned a1, u32x2 (&r)[2][4]) {
    asm volatile("ds_read_b64_tr_b16 %0, %8\n\tds_read_b64_tr_b16 %1, %8 offset:8192\n\tds_read_b64_tr_b16 %2, %8 offset:16384\n\tds_read_b64_tr_b16 %3, %8 offset:24576\n\t"
                 "ds_read_b64_tr_b16 %4, %9\n\tds_read_b64_tr_b16 %5, %9 offset:8192\n\tds_read_b64_tr_b16 %6, %9 offset:16384\n\tds_read_b64_tr_b16 %7, %9 offset:24576\n\ts_waitcnt lgkmcnt(0)"
                 : "=&v"(r[0][0]), "=&v"(r[0][1]), "=&v"(r[0][2]), "=&v"(r[0][3]), "=&v"(r[1][0]), "=&v"(r[1][1]), "=&v"(r[1][2]), "=&v"(r[1][3]) : "v"(a0), "v"(a1) : "memory");
}

namespace pg8 {
constexpr int BM = 256, BK = 64, HALF = 128, HTB = HALF * BK * 2, STAGE_BYTES = 8 * HTB, NXCD = 8;
__device__ __forceinline__ int lds_byte(int r, int c) { const int st = (r >> 4) * 2 + (c >> 5), rr = r & 15, cc = c & 31, ob = rr * 64 + cc * 2; return st * 1024 + (ob ^ (((ob >> 9) & 1) << 5)); }
__device__ __forceinline__ void stage_rc(int b, int& R, int& C) { const int st = b / 1024, sb = b % 1024, swz = sb ^ (((sb >> 9) & 1) << 5); R = (st >> 1) * 16 + swz / 64; C = (st & 1) * 32 + (swz % 64) / 2; }
__device__ __forceinline__ int perm32(int rho) { const int n = rho >> 4, i = rho & 15; return 8 * (i >> 2) + 4 * n + (i & 3); }

struct Unit { int pm, pn; };
struct Gemm { const bf16_t* A; const bf16_t* Bt; int lda, ldb, M, N, K; };

struct StaticOrder {
    int nM, nN, nwg, G, c, WGM, xpm, xpn, xn;
    __device__ void init(int M, int N, int G_, int c_, int wgm) { nM = M / BM; nN = N / BM; nwg = nM * nN; G = G_; c = c_; WGM = wgm; xn = 0; xpm = 0; xpn = 0; }
    __device__ void add_extra(int pm0, int pn0, int n) { xpm = pm0; xpn = pn0; xn = n; }
    __device__ bool next(int i, Unit& u) const {
        const long L = (long)i * G + c;
        if (L >= nwg) { const int e = (int)(L - nwg); if (e >= xn) return false; u.pm = xpm + (e & 3); u.pn = xpn + (e >> 2); return true; }
        int wgid = (int)L; { const int q = nwg / NXCD, r = nwg % NXCD, xcd = wgid % NXCD, off = wgid / NXCD; wgid = (xcd < r ? xcd * (q + 1) : r * (q + 1) + (xcd - r) * q) + off; }
        const int nig = WGM * nN, gid = wgid / nig, fm = gid * WGM, gsz = (nM - fm) < WGM ? (nM - fm) : WGM;
        u.pm = fm + ((wgid % nig) % gsz); u.pn = (wgid % nig) / gsz; return true;
    }
};

template <class Epi>
__device__ __forceinline__ void gemm_phase(LAS unsigned char* lds, const Gemm g, const StaticOrder& S, const Epi& E) {
    int tid = threadIdx.x; asm volatile("" : "+v"(tid));
    const int wid = __builtin_amdgcn_readfirstlane(tid >> 6), lane = tid & 63, wr = wid >> 2, wc = wid & 3, fr = lane & 15, fq = lane >> 4;
    const int K = g.K, nt = K / BK;
    unsigned voffA[2], voffB[2];
#pragma unroll
    for (int i = 0; i < 2; ++i) { int R, C; stage_rc(tid * 16 + i * 8192, R, C); const int Rb = Epi::PERM ? ((R & ~31) + perm32(R & 31)) : R;
        voffA[i] = (unsigned)(R * g.lda + C) * 2u; voffB[i] = (unsigned)(Rb * g.ldb + C) * 2u; }
    const size_t kstep = (size_t)(BK * 2);
    const size_t hstepA = (size_t)HALF * g.lda * 2, hstepB = (size_t)HALF * g.ldb * 2;
    const size_t tstepA = 2 * hstepA, tstepB = 2 * hstepB;
    const unsigned ldsw = (unsigned)wid * 1024u;
    const int aoff = lds_byte(wr * 64 + fr, fq * 8), boff = lds_byte(wc * 32 + fr, fq * 8);
#define PG8_SA(b, h) (((b) * 2 + (h)) * HTB)
#define PG8_SB(b, h) ((4 + (b) * 2 + (h)) * HTB)
#define PG8_STAGE(bufoff, gbase, voff) do { _Pragma("unroll") for (int _i = 0; _i < 2; ++_i) \
        __builtin_amdgcn_global_load_lds((const unsigned*)((const char*)(gbase) + (voff)[_i]), (LAS unsigned*)(lds + (bufoff) + ldsw + _i * 8192), 16, 0, 0); } while (0)
#define PG8_LDA(dst, b, h) do { _Pragma("unroll") for (int m = 0; m < 4; ++m) _Pragma("unroll") for (int k = 0; k < 2; ++k) dst[m][k] = *(const LAS bf16x8*)(lds + PG8_SA(b, h) + aoff + m * 2048 + k * 1024); } while (0)
#define PG8_LDB(dst, b, h) do { _Pragma("unroll") for (int n = 0; n < 2; ++n) _Pragma("unroll") for (int k = 0; k < 2; ++k) dst[n][k] = *(const LAS bf16x8*)(lds + PG8_SB(b, h) + boff + n * 2048 + k * 1024); } while (0)
#define PG8_MMA(ai, bj, At, Bt) do { __builtin_amdgcn_s_setprio(1); _Pragma("unroll") for (int m = 0; m < 4; ++m) _Pragma("unroll") for (int n = 0; n < 2; ++n) _Pragma("unroll") for (int k = 0; k < 2; ++k) \
        acc[ai][bj][m][n] = __builtin_amdgcn_mfma_f32_16x16x32_bf16(Bt[n][k], At[m][k], acc[ai][bj][m][n], 0, 0, 0); __builtin_amdgcn_s_setprio(0); } while (0)
#define PG8_WAIT_V(n) asm volatile("s_waitcnt vmcnt(" #n ")" ::: "memory")
#define PG8_WAIT_L(n) asm volatile("s_waitcnt lgkmcnt(" #n ")" ::: "memory")
#define PG8_BAR __builtin_amdgcn_s_barrier()
#define PG8_SCHED __builtin_amdgcn_sched_barrier(0)
    Unit cur, nxt; int ui = 0;
    if (!S.next(0, cur)) return;
    f32x4 acc[2][2][4][2];
#pragma unroll
    for (int a = 0; a < 2; ++a)
#pragma unroll
        for (int b = 0; b < 2; ++b)
#pragma unroll
            for (int m = 0; m < 4; ++m)
#pragma unroll
                for (int n = 0; n < 2; ++n) acc[a][b][m][n] = (f32x4){0.f, 0.f, 0.f, 0.f};
    bf16x8 At[4][2], B0[2][2], B1[2][2];
    const char* cA = (const char*)g.A + (size_t)cur.pm * tstepA; const char* cB = (const char*)g.Bt + (size_t)cur.pn * tstepB;
    PG8_STAGE(PG8_SB(0, 0), cB, voffB); PG8_STAGE(PG8_SB(0, 1), cB + hstepB, voffB); PG8_STAGE(PG8_SA(0, 0), cA, voffA); PG8_STAGE(PG8_SA(0, 1), cA + hstepA, voffA);
    if (wr == 1) PG8_BAR;
    PG8_WAIT_V(2); PG8_BAR;
    PG8_STAGE(PG8_SB(1, 0), cB + kstep, voffB); PG8_STAGE(PG8_SA(1, 0), cA + kstep, voffA); PG8_STAGE(PG8_SB(1, 1), cB + hstepB + kstep, voffB);
    PG8_WAIT_V(6); PG8_BAR;
    for (;;) {
        const bool has_next = S.next(ui + 1, nxt);
        const char* nA = has_next ? (const char*)g.A + (size_t)nxt.pm * tstepA : cA; const char* nB = has_next ? (const char*)g.Bt + (size_t)nxt.pn * tstepB : cB;
#pragma unroll 1
        for (int seg = 0; seg < (Epi::MIDK ? 3 : 1); ++seg) {
        const int t0 = Epi::MIDK ? seg * 8 : 0, t1 = Epi::MIDK ? (seg == 2 ? nt : seg * 8 + 8) : nt;
        if constexpr (Epi::MIDK) { if (seg > 0) { PG8_SCHED;
            asm volatile("s_cmp_lg_u32 %0, 0\n\ts_cbranch_scc1 1f\n\ts_barrier\n1:" :: "s"(wr) : "memory", "scc");
            E.mid(acc, cur, t0, wr, wc, fr, fq);
            asm volatile("s_cmp_lg_u32 %0, 1\n\ts_cbranch_scc1 1f\n\ts_barrier\n1:" :: "s"(wr) : "memory", "scc");
            PG8_SCHED; } }
#pragma unroll 1
        for (int t = t0; t < t1; t += 2) {
            const bool last = (t == nt - 2);
            const char* a1 = cA + (size_t)(t + 1) * kstep;
            const char* a2 = last ? nA : cA + (size_t)(t + 2) * kstep; const char* b2 = last ? nB : cB + (size_t)(t + 2) * kstep;
            const char* a3 = a2 + kstep; const char* b3 = b2 + kstep;
            PG8_LDB(B0, 0, 0); PG8_LDB(B1, 0, 1); PG8_SCHED; PG8_LDA(At, 0, 0); PG8_STAGE(PG8_SA(1, 1), a1 + hstepA, voffA);
            PG8_WAIT_V(8); PG8_WAIT_L(0); PG8_BAR; PG8_MMA(0, 0, At, B0); PG8_MMA(0, 1, At, B1); PG8_BAR; PG8_SCHED;
            PG8_LDA(At, 0, 1); PG8_STAGE(PG8_SB(0, 0), b2, voffB); PG8_STAGE(PG8_SB(0, 1), b2 + hstepB, voffB); PG8_STAGE(PG8_SA(0, 0), a2, voffA);
            PG8_WAIT_V(8); PG8_WAIT_L(0); PG8_BAR; PG8_MMA(1, 0, At, B0); PG8_MMA(1, 1, At, B1); PG8_BAR; PG8_SCHED;
            PG8_LDB(B0, 1, 0); PG8_LDB(B1, 1, 1); PG8_SCHED; PG8_LDA(At, 1, 0); PG8_STAGE(PG8_SA(0, 1), a2 + hstepA, voffA);
            PG8_WAIT_V(8); PG8_WAIT_L(0); PG8_BAR; PG8_MMA(0, 0, At, B0); PG8_MMA(0, 1, At, B1); PG8_BAR; PG8_SCHED;
            PG8_LDA(At, 1, 1); PG8_STAGE(PG8_SB(1, 0), b3, voffB); PG8_STAGE(PG8_SB(1, 1), b3 + hstepB, voffB); PG8_STAGE(PG8_SA(1, 0), a3, voffA);
            PG8_WAIT_V(8); PG8_WAIT_L(0); PG8_BAR; PG8_MMA(1, 0, At, B0); PG8_MMA(1, 1, At, B1); PG8_BAR; PG8_SCHED;
        }
        }
        if (wr == 0) PG8_BAR;
        E(acc, cur, wr, wc, fr, fq);
        if (!has_next) break;
#pragma unroll
        for (int a = 0; a < 2; ++a)
#pragma unroll
            for (int b = 0; b < 2; ++b)
#pragma unroll
                for (int m = 0; m < 4; ++m)
#pragma unroll
                    for (int n = 0; n < 2; ++n) acc[a][b][m][n] = (f32x4){0.f, 0.f, 0.f, 0.f};
        cur = nxt; cA = nA; cB = nB; ++ui;
        if (wr == 1) PG8_BAR;
    }
    PG8_WAIT_V(0);
    PG8_BAR;
#undef PG8_SA
#undef PG8_SB
#undef PG8_STAGE
#undef PG8_LDA
#undef PG8_LDB
#undef PG8_MMA
#undef PG8_WAIT_V
#undef PG8_WAIT_L
#undef PG8_BAR
#undef PG8_SCHED
}

struct EpiInProj {
    static constexpr bool PERM = true, MIDK = false;
    bf16_t* O;
    __device__ __forceinline__ void mid(f32x4 (&)[2][2][4][2], const Unit&, int, int, int, int, int) const {}
    __device__ __forceinline__ void operator()(const f32x4 (&acc)[2][2][4][2], const Unit& u, int wr, int wc, int fr, int fq) const {
        const int pn = u.pn;
        int act = 0;
        if (pn >= 24) act = 2; else if ((pn >= 2 && pn < 4) || (pn >= 6 && pn < 8) || (pn >= 20)) act = 1; else if (pn >= 8 && pn < 12) act = 3;
        int row0 = u.pm * BM + wr * 64 + fr, col0 = pn * BM + wc * 32 + 8 * fq; asm volatile("" : "+v"(row0), "+v"(col0));
#pragma unroll
        for (int ai = 0; ai < 2; ++ai)
#pragma unroll
            for (int m = 0; m < 4; ++m) { bf16_t* rowp = O + (size_t)(row0 + ai * HALF + m * 16) * INW + col0;
#pragma unroll
                for (int bj = 0; bj < 2; ++bj) { f32x4 v0 = acc[ai][bj][m][0], v1 = acc[ai][bj][m][1];
                    if (act == 1) {
#pragma unroll
                        for (int j = 0; j < 4; ++j) { v0[j] = v0[j] * sigmoidf_(v0[j]); v1[j] = v1[j] * sigmoidf_(v1[j]); } }
                    else if (act == 2) {
#pragma unroll
                        for (int j = 0; j < 4; ++j) { v0[j] = sigmoidf_(v0[j]); v1[j] = sigmoidf_(v1[j]); } }
                    else if (act == 3) { v0 = v0 * 0.08838834764831845f; v1 = v1 * 0.08838834764831845f; }
                    u32x4 w; w.x = cvt_pk_bf16(v0[0], v0[1]); w.y = cvt_pk_bf16(v0[2], v0[3]); w.z = cvt_pk_bf16(v1[0], v1[1]); w.w = cvt_pk_bf16(v1[2], v1[3]);
                    *(u32x4*)(rowp + bj * HALF) = w; } }
    }
};

struct EpiUp {
    static constexpr bool PERM = true, MIDK = true;
    const bf16_t* P;
    bf16_t* O;
    __device__ __forceinline__ void mid(f32x4 (&acc)[2][2][4][2], const Unit& u, int t, int wr, int wc, int fr, int fq) const {
        const int br = (t == 8) ? 0 : 1;
        int row0 = u.pm * BM + wr * 64 + fr, col0 = u.pn * BM + wc * 32 + 8 * fq; asm volatile("" : "+v"(row0), "+v"(col0));
#pragma unroll
        for (int ai = 0; ai < 2; ++ai) {
            u32x4 ga[4][2], gb[4][2];
#pragma unroll
            for (int m = 0; m < 4; ++m) { const bf16_t* gp = P + (size_t)(row0 + ai * HALF + m * 16) * INW + OFF_MG + br * 2048 + col0;
#pragma unroll
                for (int bj = 0; bj < 2; ++bj) { ga[m][bj] = *(const u32x4*)(gp + bj * HALF); gb[m][bj] = *(const u32x4*)(gp + 2048 + bj * HALF); } }
#pragma unroll
            for (int m = 0; m < 4; ++m)
#pragma unroll
                for (int bj = 0; bj < 2; ++bj) { const u32x4 a_ = ga[m][bj], b_ = gb[m][bj];
                    f32x4 r0, r1;
                    r0[0] = bflo(a_.x) * __builtin_amdgcn_rcpf(bflo(b_.x)); r0[1] = bfhi(a_.x) * __builtin_amdgcn_rcpf(bfhi(b_.x));
                    r0[2] = bflo(a_.y) * __builtin_amdgcn_rcpf(bflo(b_.y)); r0[3] = bfhi(a_.y) * __builtin_amdgcn_rcpf(bfhi(b_.y));
                    r1[0] = bflo(a_.z) * __builtin_amdgcn_rcpf(bflo(b_.z)); r1[1] = bfhi(a_.z) * __builtin_amdgcn_rcpf(bfhi(b_.z));
                    r1[2] = bflo(a_.w) * __builtin_amdgcn_rcpf(bflo(b_.w)); r1[3] = bfhi(a_.w) * __builtin_amdgcn_rcpf(bfhi(b_.w));
                    acc[ai][bj][m][0] = acc[ai][bj][m][0] * r0; acc[ai][bj][m][1] = acc[ai][bj][m][1] * r1; }
            asm volatile("" ::: "memory"); }
    }
    __device__ __forceinline__ void operator()(const f32x4 (&acc)[2][2][4][2], const Unit& u, int wr, int wc, int fr, int fq) const {
        int row0 = u.pm * BM + wr * 64 + fr, col0 = u.pn * BM + wc * 32 + 8 * fq; asm volatile("" : "+v"(row0), "+v"(col0));
#pragma unroll
        for (int ai = 0; ai < 2; ++ai) {
            u32x4 gc[4][2];
#pragma unroll
            for (int m = 0; m < 4; ++m) { const bf16_t* gp = P + (size_t)(row0 + ai * HALF + m * 16) * INW + OFF_MG + 2 * 2048 + col0;
#pragma unroll
                for (int bj = 0; bj < 2; ++bj) gc[m][bj] = *(const u32x4*)(gp + bj * HALF); }
#pragma unroll
            for (int m = 0; m < 4; ++m) { bf16_t* rowp = O + (size_t)(row0 + ai * HALF + m * 16) * LDX + col0;
#pragma unroll
                for (int bj = 0; bj < 2; ++bj) { const u32x4 g_ = gc[m][bj];
                    const f32x4 v0 = acc[ai][bj][m][0], v1 = acc[ai][bj][m][1];
                    u32x4 w; w.x = cvt_pk_bf16(v0[0] * bflo(g_.x), v0[1] * bfhi(g_.x)); w.y = cvt_pk_bf16(v0[2] * bflo(g_.y), v0[3] * bfhi(g_.y));
                    w.z = cvt_pk_bf16(v1[0] * bflo(g_.z), v1[1] * bfhi(g_.z)); w.w = cvt_pk_bf16(v1[2] * bflo(g_.w), v1[3] * bfhi(g_.w));
                    *(u32x4*)(rowp + bj * HALF) = w; } }
            asm volatile("" ::: "memory"); }
    }
};

struct EpiOut {
    static constexpr bool PERM = true, MIDK = false;
    const float* xold_f32; const bf16_t* xold_b16; bf16_t* xnew_b16; const float* xold_ctx; float* xnew_ctx; const float* mod;
    __device__ __forceinline__ void mid(f32x4 (&)[2][2][4][2], const Unit&, int, int, int, int, int) const {}
    __device__ __forceinline__ void operator()(const f32x4 (&acc)[2][2][4][2], const Unit& u, int wr, int wc, int fr, int fq) const {
        const bool isctx = u.pm >= (MLAT / BM);
        const int mrow = isctx ? 4 : (u.pm >> 4);
        int row0 = u.pm * BM + wr * 64 + fr, col0 = u.pn * BM + wc * 32 + 8 * fq; asm volatile("" : "+v"(row0), "+v"(col0));
        f32x4 gv[2][2];
#pragma unroll
        for (int bj = 0; bj < 2; ++bj)
#pragma unroll
            for (int n = 0; n < 2; ++n) gv[bj][n] = *(const f32x4*)(mod + mrow * 6144 + 4096 + col0 + bj * HALF + n * 4);
        if (isctx) {
            const float* xo = xold_ctx - (size_t)MLAT * D; float* xn = xnew_ctx - (size_t)MLAT * D;
#pragma unroll
            for (int am = 0; am < 4; ++am) {
                const int ai = am >> 1, mb = (am & 1) * 2;
                f32x4 xv[2][2][2];
#pragma unroll
                for (int mm = 0; mm < 2; ++mm) { const size_t off = (size_t)(row0 + ai * HALF + (mb + mm) * 16) * D + col0;
#pragma unroll
                    for (int bj = 0; bj < 2; ++bj)
#pragma unroll
                        for (int n = 0; n < 2; ++n) xv[mm][bj][n] = *(const f32x4*)(xo + off + bj * HALF + n * 4); }
#pragma unroll
                for (int mm = 0; mm < 2; ++mm) { const size_t off = (size_t)(row0 + ai * HALF + (mb + mm) * 16) * D + col0;
#pragma unroll
                    for (int bj = 0; bj < 2; ++bj)
#pragma unroll
                        for (int n = 0; n < 2; ++n) *(f32x4*)(xn + off + bj * HALF + n * 4) = xv[mm][bj][n] + gv[bj][n] * acc[ai][bj][mb + mm][n]; }
                asm volatile("" ::: "memory"); }
        } else if (xold_b16) {
#pragma unroll
            for (int ai = 0; ai < 2; ++ai) {
                u32x4 xb[4][2];
#pragma unroll
                for (int m = 0; m < 4; ++m) { const size_t off = (size_t)(row0 + ai * HALF + m * 16) * D + col0;
#pragma unroll
                    for (int bj = 0; bj < 2; ++bj) xb[m][bj] = *(const u32x4*)(xold_b16 + off + bj * HALF); }
#pragma unroll
                for (int m = 0; m < 4; ++m) { const size_t off = (size_t)(row0 + ai * HALF + m * 16) * D + col0;
#pragma unroll
                    for (int bj = 0; bj < 2; ++bj) { const u32x4 x_ = xb[m][bj]; const f32x4 a0 = acc[ai][bj][m][0], a1 = acc[ai][bj][m][1], g0 = gv[bj][0], g1 = gv[bj][1];
                        u32x4 w; w.x = cvt_pk_bf16(bflo(x_.x) + g0[0] * a0[0], bfhi(x_.x) + g0[1] * a0[1]); w.y = cvt_pk_bf16(bflo(x_.y) + g0[2] * a0[2], bfhi(x_.y) + g0[3] * a0[3]);
                        w.z = cvt_pk_bf16(bflo(x_.z) + g1[0] * a1[0], bfhi(x_.z) + g1[1] * a1[1]); w.w = cvt_pk_bf16(bflo(x_.w) + g1[2] * a1[2], bfhi(x_.w) + g1[3] * a1[3]);
                        *(u32x4*)(xnew_b16 + off + bj * HALF) = w; } }
                asm volatile("" ::: "memory"); }
        } else {
#pragma unroll
            for (int am = 0; am < 4; ++am) {
                const int ai = am >> 1, mb = (am & 1) * 2;
                f32x4 xv[2][2][2];
#pragma unroll
                for (int mm = 0; mm < 2; ++mm) { const size_t off = (size_t)(row0 + ai * HALF + (mb + mm) * 16) * D + col0;
#pragma unroll
                    for (int bj = 0; bj < 2; ++bj)
#pragma unroll
                        for (int n = 0; n < 2; ++n) xv[mm][bj][n] = *(const f32x4*)(xold_f32 + off + bj * HALF + n * 4); }
#pragma unroll
                for (int mm = 0; mm < 2; ++mm) { const size_t off = (size_t)(row0 + ai * HALF + (mb + mm) * 16) * D + col0;
#pragma unroll
                    for (int bj = 0; bj < 2; ++bj) { const f32x4 v0 = xv[mm][bj][0] + gv[bj][0] * acc[ai][bj][mb + mm][0], v1 = xv[mm][bj][1] + gv[bj][1] * acc[ai][bj][mb + mm][1];
                        u32x4 w; w.x = cvt_pk_bf16(v0[0], v0[1]); w.y = cvt_pk_bf16(v0[2], v0[3]); w.z = cvt_pk_bf16(v1[0], v1[1]); w.w = cvt_pk_bf16(v1[2], v1[3]);
                        *(u32x4*)(xnew_b16 + off + bj * HALF) = w; } }
                asm volatile("" ::: "memory"); }
        }
    }
};
}

struct Args {
    const float* x; const float* c; const float* ctx; const float* c_ctx; const float* w_ada; const float* b_ada; const float* norm_g; const float* w_in;
    const float* w_fourier; const float* w_pool; const float* pool_scale; const float* decay_logit; const float* w_up_f; const float* w_up_p; const float* w_up_r;
    const float* w_out; const float* final_g; float* out; unsigned char* ws;
    int ph_lo, ph_hi;
};

struct Frame {
    LAS unsigned char* lds; int tid, lane, wave, G, bid;
};

__device__ __forceinline__ void transpose_item(const float* W, int N, bf16_t* WT, int ldo, int koff, LAS float* scr, int item, int lane) {
    const int nblk = N / 64, kb = item / nblk, nb = item % nblk, k0 = 64 * kb, n0 = 64 * nb;
    float wv[64];
#pragma unroll
    for (int i = 0; i < 64; ++i) wv[i] = W[(size_t)(k0 + i) * N + n0 + lane];
#pragma unroll
    for (int i = 0; i < 64; ++i) scr[i * 65 + lane] = wv[i];
    LDS_WAIT();
    const int c = lane & 7;
#pragma unroll
    for (int j = 0; j < 8; ++j) { const int n = (lane >> 3) + 8 * j; const LAS float* s_ = scr + (8 * c) * 65 + n;
        u32x4 o; o.x = pk2(s_[0 * 65], s_[1 * 65]); o.y = pk2(s_[2 * 65], s_[3 * 65]); o.z = pk2(s_[4 * 65], s_[5 * 65]); o.w = pk2(s_[6 * 65], s_[7 * 65]);
        *(u32x4*)(WT + (size_t)(n0 + n) * ldo + koff + k0 + 8 * c) = o; }
    LDS_WAIT();
}

__device__ __forceinline__ void weights_layer(const Args& a, const Frame& F, int l, int parts, int widx, int nwk) {
    LAS float* scr = (LAS float*)(F.lds + F.wave * 16640);
    const int gw = widx * 8 + F.wave, NGW = nwk * 8;
    bf16_t* WIN = (bf16_t*)(a.ws + WS_WIN); bf16_t* WUP = (bf16_t*)(a.ws + WS_WUP); bf16_t* WOUT = (bf16_t*)(a.ws + WS_WOUT);
    constexpr int I_IN = 32 * 192, I_UF = 8 * 32, I_UP = 8 * 32, I_UR = 16 * 32, I_O = 32 * 32;
    if (parts & 1) for (int it = gw; it < I_IN / 2; it += NGW) transpose_item(a.w_in + (size_t)l * D * INW, INW, WIN, LDX, 0, scr, it, F.lane);
    if (parts & 16) for (int it = I_IN / 2 + gw; it < I_IN; it += NGW) transpose_item(a.w_in + (size_t)l * D * INW, INW, WIN, LDX, 0, scr, it, F.lane);
    if (parts & 2) for (int it = gw; it < I_UF + I_UP + I_UR; it += NGW) {
        int r = it;
        if (r < I_UF) { transpose_item(a.w_up_f + (size_t)l * 512 * D, D, WUP, LDX, 0, scr, r, F.lane); continue; } r -= I_UF;
        if (r < I_UP) { transpose_item(a.w_up_p + (size_t)l * 512 * D, D, WUP, LDX, 512, scr, r, F.lane); continue; } r -= I_UP;
        transpose_item(a.w_up_r + (size_t)l * 1024 * D, D, WUP, LDX, 1024, scr, r, F.lane);
    }
    if (parts & 4) for (int it = gw; it < I_O; it += NGW) transpose_item(a.w_out + (size_t)l * D * D, D, WOUT, LDX, 0, scr, it, F.lane);
    if (parts & 8) {
        const int gt = widx * 512 + F.tid, NT = nwk * 512;
        bf16_t* WCST = (bf16_t*)(a.ws + WS_WCST); bf16_t* WPT = (bf16_t*)(a.ws + WS_WPT);
        const float* wf = a.w_fourier + (size_t)l * 4 * 128 * 128; const float* wp = a.w_pool + (size_t)l * 4 * 128 * 128;
        for (int o = gt; o < 4 * 8 * 128 * 32; o += NT) {
            const int jj = o & 7, fq = (o >> 3) & 3, d = (o >> 5) & 127, cbk = (o >> 12) & 7, g = o >> 15;
            const int cch = cbk * 16 + fq * 4 + (jj & 3); const bool is_sin = jj >= 4;
            float s = 0.f;
            for (int dp = 0; dp < 128; ++dp) { const float rev = (float)((cch * dp) & 127) * (1.0f / 128.0f);
                const float tw = is_sin ? sin_rev(rev) : cos_rev(rev); s += tw * wf[(g * 128 + dp) * 128 + d]; }
            WCST[o] = (bf16_t)f2bf(s * 0.08838834764831845f);
        }
        for (int o = gt; o < 4 * 128 * 128; o += NT) { const int cch = o & 127, d = (o >> 7) & 127, g = o >> 14; WPT[o] = (bf16_t)f2bf(wp[(g * 128 + cch) * 128 + d]); }
    }
}

__device__ __forceinline__ void p0_misc(const Args& a, const Frame& F) {
    const int gt = F.bid * 512 + F.tid, NT = F.G * 512;
    bf16_t* A1 = (bf16_t*)(a.ws + WS_A1); bf16_t* A3 = (bf16_t*)(a.ws + WS_A3); float* LG = (float*)(a.ws + WS_LG);
    for (int o = gt; o < 128 * 64; o += NT) { const int aa = o & 63, r = o >> 6, m1 = r & 63; const float rev = (float)((m1 * aa) & 63) * (1.0f / 64.0f);
        A1[o] = (bf16_t)f2bf(r < 64 ? cos_rev(rev) : -sin_rev(rev)); }
    for (int o = gt; o < 128 * 128; o += NT) { const int k = o & 127, r = o >> 7, m2 = r & 63, n2 = k >> 1, ri = k & 1; const float rev = (float)((m2 * n2) & 63) * (1.0f / 64.0f);
        const float cs = cos_rev(rev), sn = sin_rev(rev);
        const float v = (r < 64) ? (ri == 0 ? cs : sn) : (ri == 0 ? -sn : cs);
        A3[o] = (bf16_t)f2bf(v); }
    for (int o = gt; o < 32; o += NT) { const float z = a.decay_logit[o]; LG[o] = -log1pf(expf(-z)); }
}

__device__ __forceinline__ void p0_mod(const Args& a, const Frame& F) {
    LAS float* sc = (LAS float*)F.lds;
    LAS float* red = (LAS float*)(F.lds + 5 * 2048 * 4);
    float* MOD = (float*)(a.ws + WS_MOD);
    bool have = false;
    for (int it = F.bid; it < 2 * 96; it += F.G) {
        if (!have) {
            for (int o = F.tid; o < 5 * 2048; o += 512) { const float v = (o < 4 * 2048) ? a.c[o] : a.c_ctx[o - 4 * 2048]; sc[o] = v * sigmoidf_(v); }
            have = true;
        }
        __syncthreads();
        const int l = it / 96, cg0 = (it % 96) * 64;
        const int cq = F.tid & 15, ks = F.tid >> 4;
        const float* W = a.w_ada + (size_t)l * D * 6144 + cg0 + cq * 4;
        f32x4 ac[5];
#pragma unroll
        for (int r = 0; r < 5; ++r) ac[r] = (f32x4){0.f, 0.f, 0.f, 0.f};
#pragma unroll 16
        for (int kk = 0; kk < 64; ++kk) { const int k = ks * 64 + kk; const f32x4 w = *(const f32x4*)(W + (size_t)k * 6144);
#pragma unroll
            for (int r = 0; r < 5; ++r) ac[r] += w * sc[r * 2048 + k]; }
#pragma unroll
        for (int r = 0; r < 5; ++r)
#pragma unroll
            for (int j = 0; j < 4; ++j) red[(ks * 16 + cq) * 20 + r * 4 + j] = ac[r][j];
        __syncthreads();
        if (F.tid < 320) { const int cq2 = F.tid / 20, rj = F.tid % 20, r = rj >> 2, j = rj & 3; float s = 0.f;
            for (int k2 = 0; k2 < 32; ++k2) s += red[(k2 * 16 + cq2) * 20 + rj];
            const int col = cg0 + cq2 * 4 + j;
            MOD[(l * 5 + r) * 6144 + col] = s + a.b_ada[l * 6144 + col]; }
        __syncthreads();
    }
}

__device__ __forceinline__ void prenorm_b16(const Args& a, const Frame& F, int l) {
    const int gw = F.bid * 8 + F.wave, NGW = F.G * 8;
    const float* MOD = (const float*)(a.ws + WS_MOD) + (size_t)l * 5 * 6144;
    const bf16_t* xb = (const bf16_t*)a.out; const float* ng = a.norm_g + (size_t)l * D;
    bf16_t* XN = (bf16_t*)(a.ws + WS_XN);
    u32x4 nx[4];
    if (gw < MLAT) {
#pragma unroll
        for (int j = 0; j < 4; ++j) nx[j] = *(const u32x4*)(xb + (size_t)gw * D + (j * 64 + F.lane) * 8); }
    for (int m = gw; m < MLAT; m += NGW) {
        const int mrow = m >> 12;
        float v[4][8]; float s = 0.f;
#pragma unroll
        for (int j = 0; j < 4; ++j) { unpack8(nx[j], v[j]);
#pragma unroll
            for (int e = 0; e < 8; ++e) s += v[j][e] * v[j][e]; }
        const int m2 = m + NGW;
        if (m2 < MLAT) {
#pragma unroll
            for (int j = 0; j < 4; ++j) nx[j] = *(const u32x4*)(xb + (size_t)m2 * D + (j * 64 + F.lane) * 8); }
#pragma unroll
        for (int o = 1; o < 64; o <<= 1) s += __shfl_xor(s, o);
        const float r = 1.0f / sqrtf(s * (1.0f / D) + EPS);
#pragma unroll
        for (int j = 0; j < 4; ++j) { const int col = (j * 64 + F.lane) * 8; float h[8];
#pragma unroll
            for (int hh = 0; hh < 2; ++hh) { const f32x4 g = *(const f32x4*)(ng + col + 4 * hh), sh = *(const f32x4*)(MOD + mrow * 6144 + col + 4 * hh), sc = *(const f32x4*)(MOD + mrow * 6144 + 2048 + col + 4 * hh);
#pragma unroll
                for (int e = 0; e < 4; ++e) h[4 * hh + e] = (v[j][4 * hh + e] * r) * g[e] * (sc[e] + 1.0f) + sh[e]; }
            *(u32x4*)(XN + (size_t)m * LDX + col) = pack8(h); }
    }
}
__device__ __forceinline__ void prenorm(const Args& a, const Frame& F, int l, int m_lo) {
    const int gw = m_lo + F.bid * 8 + F.wave, NGW = F.G * 8;
    const float* MOD = (const float*)(a.ws + WS_MOD) + (size_t)l * 5 * 6144;
    const float* xl = (l == 0) ? a.x : a.out; const float* xc = (l == 0) ? a.ctx : (const float*)(a.ws + WS_CTX1);
    const float* ng = a.norm_g + (size_t)l * D;
    bf16_t* XN = (bf16_t*)(a.ws + WS_XN);
    f32x4 v[8], nx[8];
    if (gw < MTOT) { const f32x4* xr = (const f32x4*)(gw >= MLAT ? xc + (size_t)(gw - MLAT) * D : xl + (size_t)gw * D) + F.lane;
#pragma unroll
        for (int j = 0; j < 8; ++j) nx[j] = xr[64 * j]; }
    for (int m = gw; m < MTOT; m += NGW) {
        const bool isctx = m >= MLAT; const int mrow = isctx ? 4 : (m >> 12);
#pragma unroll
        for (int j = 0; j < 8; ++j) v[j] = nx[j];
        const int m2 = m + NGW;
        if (m2 < MTOT) { const f32x4* xr = (const f32x4*)(m2 >= MLAT ? xc + (size_t)(m2 - MLAT) * D : xl + (size_t)m2 * D) + F.lane;
#pragma unroll
            for (int j = 0; j < 8; ++j) nx[j] = xr[64 * j]; }
        float s = 0.f;
#pragma unroll
        for (int j = 0; j < 8; ++j) s += (v[j].x * v[j].x + v[j].y * v[j].y) + (v[j].z * v[j].z + v[j].w * v[j].w);
#pragma unroll
        for (int o = 1; o < 64; o <<= 1) s += __shfl_xor(s, o);
        const float r = 1.0f / sqrtf(s * (1.0f / D) + EPS);
        const f32x4* gp = (const f32x4*)ng + F.lane; const f32x4* shp = (const f32x4*)(MOD + mrow * 6144) + F.lane; const f32x4* scp = (const f32x4*)(MOD + mrow * 6144 + 2048) + F.lane;
        u32x2* o8 = (u32x2*)(XN + (size_t)m * LDX) + F.lane;
#pragma unroll
        for (int j = 0; j < 8; ++j) { const f32x4 g = gp[64 * j], sh = shp[64 * j], sc = scp[64 * j];
            const f32x4 h = (v[j] * r) * g * (sc + 1.0f) + sh;
            u32x2 w; w.x = pk2(h.x, h.y); w.y = pk2(h.z, h.w); o8[64 * j] = w; }
    }
}

constexpr int LDP = 136;
__device__ __forceinline__ void chunk_decode(int it, int& b, int& h, int& cc, int& rowbase, bool& is_lat, int& posbase) {
    const int bh = it / NCH; cc = it % NCH; b = bh >> 3; h = bh & 7;
    if (cc < NCH_C) { is_lat = false; rowbase = MLAT + b * CTXL + cc * CH; posbase = cc * CH; }
    else { is_lat = true; rowbase = b * SEQ + (cc - NCH_C) * CH; posbase = (cc - NCH_C) * CH; }
}
__device__ __forceinline__ void load_vt(const bf16_t* proj, int rowbase, int h, LAS bf16_t* VT, int tid) {
#pragma unroll
    for (int q = 0; q < 4; ++q) { const int u = tid + q * 512, j = u & 127, e8 = (u >> 7) * 8;
        const u32x4 v = *(const u32x4*)(proj + (size_t)(rowbase + j) * INW + OFF_V + h * DK + e8);
        LAS bf16_t* p = VT + e8 * LDP + j;
        p[0 * LDP] = (bf16_t)(v.x & 0xffff); p[1 * LDP] = (bf16_t)(v.x >> 16); p[2 * LDP] = (bf16_t)(v.y & 0xffff); p[3 * LDP] = (bf16_t)(v.y >> 16);
        p[4 * LDP] = (bf16_t)(v.z & 0xffff); p[5 * LDP] = (bf16_t)(v.z >> 16); p[6 * LDP] = (bf16_t)(v.w & 0xffff); p[7 * LDP] = (bf16_t)(v.w >> 16); }
}

__device__ __forceinline__ void kv_phase(const Args& a, const Frame& F, int l, bool norope = false) {
    bf16_t* proj = (bf16_t*)(a.ws + WS_PROJ); bf16_t* KVT = (bf16_t*)(a.ws + WS_KVT); const float* LG = (const float*)(a.ws + WS_LG) + l * 16;
    LAS bf16_t* KFT = (LAS bf16_t*)F.lds; LAS bf16_t* KBT = KFT + 128 * LDP; LAS bf16_t* VT = KBT + 128 * LDP;
    const int fr = F.lane & 15, fq = F.lane >> 4;
    for (int it = F.bid; it < 32 * NCH; it += F.G) {
        int b, h, cc, rowbase, posbase; bool is_lat; chunk_decode(it, b, h, cc, rowbase, is_lat, posbase);
        if (norope) is_lat = false;
        const float lgf = LG[h], lgb = LG[8 + h];
        u32x4 kx1[2], kx2[2], qx1[2], qx2[2], vreg[4];
#pragma unroll
        for (int q = 0; q < 2; ++q) { const int u = F.tid + q * 512, j = u >> 3, sub = u & 7, base = (sub >> 2) * 64, i0 = (sub & 3) * 8;
            const bf16_t* kp = proj + (size_t)(rowbase + j) * INW + OFF_K + h * DK + base + i0; kx1[q] = *(const u32x4*)kp; kx2[q] = *(const u32x4*)(kp + 32);
            if (is_lat) { const bf16_t* qp = proj + (size_t)(rowbase + j) * INW + OFF_Q + h * DK + base + i0; qx1[q] = *(const u32x4*)qp; qx2[q] = *(const u32x4*)(qp + 32); } }
#pragma unroll
        for (int q = 0; q < 4; ++q) { const int u = F.tid + q * 512, vr = u >> 4, vc = u & 15; vreg[q] = *(const u32x4*)(proj + (size_t)(rowbase + vr) * INW + OFF_V + h * DK + vc * 8); }
#pragma unroll
        for (int q = 0; q < 2; ++q) {
            const int u = F.tid + q * 512, j = u >> 3, sub = u & 7, base = (sub >> 2) * 64, i0 = (sub & 3) * 8;
            const int n = posbase + j; const float pos = (float)(base == 0 ? (n >> 6) : (n & 63));
            float cs[8], sn[8];
#pragma unroll
            for (int e = 0; e < 8; ++e) { const float inv = exp2f(-(float)(i0 + e) * (13.287712379549449f / 32.0f)); float rev = pos * inv * 0.15915494309189535f; rev -= floorf(rev);
                cs[e] = is_lat ? cos_rev(rev) : 1.0f; sn[e] = is_lat ? sin_rev(rev) : 0.0f; }
            bf16_t* kp = proj + (size_t)(rowbase + j) * INW + OFF_K + h * DK + base + i0;
            float x1[8], x2[8], o1[8], o2[8];
            unpack8(kx1[q], x1); unpack8(kx2[q], x2);
#pragma unroll
            for (int e = 0; e < 8; ++e) { o1[e] = x1[e] * cs[e] - x2[e] * sn[e]; o2[e] = x1[e] * sn[e] + x2[e] * cs[e]; }
            if (is_lat) { *(u32x4*)kp = pack8(o1); *(u32x4*)(kp + 32) = pack8(o2); }
            const float wf = __expf(lgf * (float)(CH - 1 - j)), wb = __expf(lgb * (float)j);
#pragma unroll
            for (int e = 0; e < 8; ++e) { x1[e] = o1[e] * wf; x2[e] = o2[e] * wf; o1[e] *= wb; o2[e] *= wb; }
            {
                const unsigned c1 = (unsigned)(base + i0) >> 3, c2 = c1 + 4;
                *(LAS u32x4*)((LAS unsigned char*)KFT + off_b(j, c1)) = pack8(x1); *(LAS u32x4*)((LAS unsigned char*)KFT + off_b(j, c2)) = pack8(x2);
                *(LAS u32x4*)((LAS unsigned char*)KBT + off_b(j, c1)) = pack8(o1); *(LAS u32x4*)((LAS unsigned char*)KBT + off_b(j, c2)) = pack8(o2); }
            if (is_lat) {
                bf16_t* qp = proj + (size_t)(rowbase + j) * INW + OFF_Q + h * DK + base + i0;
                unpack8(qx1[q], x1); unpack8(qx2[q], x2);
#pragma unroll
                for (int e = 0; e < 8; ++e) { o1[e] = x1[e] * cs[e] - x2[e] * sn[e]; o2[e] = x1[e] * sn[e] + x2[e] * cs[e]; }
                *(u32x4*)qp = pack8(o1); *(u32x4*)(qp + 32) = pack8(o2);
            }
        }
#pragma unroll
        for (int q = 0; q < 4; ++q) { const int u = F.tid + q * 512, vr = u >> 4, vc = u & 15; *(LAS u32x4*)((LAS unsigned char*)VT + off_b(vr, vc)) = vreg[q]; }
        __syncthreads();
        const int dt = F.wave;
        bf16x8 aff[4], afb[4];
        {
            const unsigned t0 = tr_addr(8 * fq, dt, F.lane), t1 = tr_addr(8 * fq + 4, dt, F.lane);
            u32x2 rf[2][4], rb[2][4];
            tr_read8((unsigned)(unsigned long)KFT + t0, (unsigned)(unsigned long)KFT + t1, rf);
            tr_read8((unsigned)(unsigned long)KBT + t0, (unsigned)(unsigned long)KBT + t1, rb);
#pragma unroll
            for (int ks = 0; ks < 4; ++ks) { u32x4 w; w.x = rf[0][ks].x; w.y = rf[0][ks].y; w.z = rf[1][ks].x; w.w = rf[1][ks].y; aff[ks] = as_bf16x8(w);
                u32x4 w2; w2.x = rb[0][ks].x; w2.y = rb[0][ks].y; w2.z = rb[1][ks].x; w2.w = rb[1][ks].y; afb[ks] = as_bf16x8(w2); }
        }
        const unsigned vbase = (unsigned)(unsigned long)VT;
        bf16_t* dstf = KVT + (size_t)it * 2 * 16384; bf16_t* dstb = dstf + 16384;
#pragma unroll
        for (int et = 0; et < 8; ++et) {
            u32x2 r[2][4];
            tr_read8(vbase + tr_addr(8 * fq, et, F.lane), vbase + tr_addr(8 * fq + 4, et, F.lane), r);
            f32x4 accf = (f32x4){0.f, 0.f, 0.f, 0.f}, accb = (f32x4){0.f, 0.f, 0.f, 0.f};
#pragma unroll
            for (int ks = 0; ks < 4; ++ks) { u32x4 bw; bw.x = r[0][ks].x; bw.y = r[0][ks].y; bw.z = r[1][ks].x; bw.w = r[1][ks].y; const bf16x8 bv = as_bf16x8(bw);
                accf = mfma16(aff[ks], bv, accf); accb = mfma16(afb[ks], bv, accb); }
            u32x2 wf; wf.x = pk2(accf[0], accf[1]); wf.y = pk2(accf[2], accf[3]); *(u32x2*)(dstf + (et * 16 + fr) * 128 + dt * 16 + fq * 4) = wf;
            u32x2 wb; wb.x = pk2(accb[0], accb[1]); wb.y = pk2(accb[2], accb[3]); *(u32x2*)(dstb + (et * 16 + fr) * 128 + dt * 16 + fq * 4) = wb;
        }
        __syncthreads();
    }
}

__device__ __forceinline__ void fourier1(const Args& a, const Frame& F, int l) {
    const bf16_t* proj = (const bf16_t*)(a.ws + WS_PROJ); const bf16_t* A1 = (const bf16_t*)(a.ws + WS_A1); bf16_t* TP = (bf16_t*)(a.ws + WS_TP);
    const int fr = F.lane & 15, fq = F.lane >> 4, w = F.wave;
    LAS bf16_t* XS = (LAS bf16_t*)F.lds;
    {
        bf16x8 af[8][2];
#pragma unroll
        for (int t = 0; t < 8; ++t)
#pragma unroll
            for (int ks = 0; ks < 2; ++ks) af[t][ks] = *(const bf16x8*)(A1 + (t * 16 + fr) * 64 + ks * 32 + fq * 8);
        for (int it = F.bid; it < 256; it += F.G) {
            const int cblk = it & 15, nb = (it >> 4) & 3, b = it >> 6;
            u32x4 xr[8];
#pragma unroll
            for (int q = 0; q < 8; ++q) { const int u = F.tid + q * 512, row = u >> 2, ch = u & 3, aa = row >> 4, n2l = row & 15;
                xr[q] = *(const u32x4*)(proj + (size_t)(b * SEQ + 64 * aa + nb * 16 + n2l) * INW + OFF_FX + cblk * 32 + ch * 8); }
#pragma unroll
            for (int q = 0; q < 8; ++q) { const int u = F.tid + q * 512, row = u >> 2, ch = u & 3; *(LAS u32x4*)(XS + row * 40 + ch * 8) = xr[q]; }
            __syncthreads();
            const int n2 = nb * 16 + fr;
            float tcs[4][4], tsn[4][4];
#pragma unroll
            for (int t = 0; t < 4; ++t)
#pragma unroll
                for (int r = 0; r < 4; ++r) { const int m1 = t * 16 + fq * 4 + r; const float rev = (float)((m1 * n2) & 4095) * (1.0f / 4096.0f); tcs[t][r] = cos_rev(rev) * (1.0f / 64.0f); tsn[t][r] = sin_rev(rev) * (1.0f / 64.0f); }
#pragma unroll 1
            for (int cl = 0; cl < 4; ++cl) {
                const int c = w * 4 + cl;
                bf16x8 bfrag[2];
#pragma unroll
                for (int ks = 0; ks < 2; ++ks)
#pragma unroll
                    for (int jj = 0; jj < 8; ++jj) bfrag[ks][jj] = (short)XS[((ks * 32 + fq * 8 + jj) * 16 + fr) * 40 + c];
                f32x4 acc[8];
#pragma unroll
                for (int t = 0; t < 8; ++t) { acc[t] = (f32x4){0.f, 0.f, 0.f, 0.f};
#pragma unroll
                    for (int ks = 0; ks < 2; ++ks) acc[t] = mfma16(af[t][ks], bfrag[ks], acc[t]); }
                const int cg_ = cblk * 32 + c;
#pragma unroll
                for (int t = 0; t < 4; ++t)
#pragma unroll
                    for (int r = 0; r < 4; ++r) { const int m1 = t * 16 + fq * 4 + r; const float tr = acc[t][r], ti = acc[t + 4][r];
                        *(unsigned*)(TP + ((size_t)(b * 64 + m1) * 512 + cg_) * 128 + 2 * n2) = pk2(tr * tcs[t][r] + ti * tsn[t][r], ti * tcs[t][r] - tr * tsn[t][r]); }
            }
            __syncthreads();
        }
    }
    if (l == 0) {
        const int gt = F.bid * 512 + F.tid, NT = F.G * 512;
        for (int o = gt; o < 4 * 4 * 64 * 512; o += NT) {
            const int c = o & 511, n2 = (o >> 9) & 63, m1 = (o >> 15) & 3, b = o >> 17;
            float tr = 0.f, ti = 0.f;
#pragma unroll
            for (int aa = 0; aa < 4; ++aa) { const float x = bf2f(proj[(size_t)(MLAT + b * CTXL + 64 * aa + n2) * INW + OFF_FX + c]); const float rev = (float)((m1 * aa) & 3) * 0.25f;
                tr += x * cos_rev(rev); ti -= x * sin_rev(rev); }
            const float rev = (float)((m1 * n2) & 255) * (1.0f / 256.0f); const float cs = cos_rev(rev), sn = sin_rev(rev);
            const float tr2 = (tr * cs + ti * sn) * (1.0f / 16.0f), ti2 = (ti * cs - tr * sn) * (1.0f / 16.0f);
            *(unsigned*)(TP + TP_CTX_OFF + ((size_t)(b * 4 + m1) * 512 + c) * 128 + 2 * n2) = pk2(tr2, ti2);
        }
    }
}

template <int G>
__device__ __forceinline__ void pool_item(const bf16_t* proj, const LAS bf16_t* WPL, const LAS bf16_t* ROWS, bf16_t* AB, const float* psc, int row0, int t, int N, int tl, int fr, int fq) {
    constexpr int half = 1 << G;
    const int lo = max(t - half, 0), hi = min(t + half, N); const float rc = 1.0f / (float)(hi - lo);
    bf16x8 af[4];
#pragma unroll
    for (int ks = 0; ks < 4; ++ks) {
        const LAS bf16_t* cp = ROWS + (tl - half) * LDP + ks * 32 + fq * 8;
        float s[8], me[8], f[8];
#pragma unroll
        for (int e = 0; e < 8; ++e) s[e] = 0.f;
#pragma unroll
        for (int dd = 0; dd < 2 * half; ++dd) { unpack8(*(const LAS u32x4*)(cp + dd * LDP), f);
#pragma unroll
            for (int e = 0; e < 8; ++e) s[e] += f[e]; }
        unpack8(*(const LAS u32x4*)(cp + half * LDP), me);
#pragma unroll
        for (int e = 0; e < 8; ++e) s[e] = s[e] * rc - me[e];
        af[ks] = as_bf16x8(pack8(s));
    }
    const size_t row = (size_t)(row0 + fr);
#pragma unroll
    for (int dt = 0; dt < 8; ++dt) { f32x4 acc = (f32x4){0.f, 0.f, 0.f, 0.f};
#pragma unroll
        for (int ks = 0; ks < 4; ++ks) { const bf16x8 wv = *(const LAS bf16x8*)(WPL + (dt * 16 + fr) * LDP + ks * 32 + fq * 8); acc = mfma16(wv, af[ks], acc); }
        const int d0 = G * 128 + dt * 16 + fq * 4; const f32x4 ps = *(const f32x4*)(psc + d0); const u32x2 gv = *(const u32x2*)(proj + row * INW + OFF_PG + d0);
        u32x2 o; o.x = pk2(acc[0] * ps[0] * bflo(gv.x), acc[1] * ps[1] * bfhi(gv.x)); o.y = pk2(acc[2] * ps[2] * bflo(gv.y), acc[3] * ps[3] * bfhi(gv.y));
        *(u32x2*)(AB + row * LDX + 512 + d0) = o;
        if (dt & 1) asm volatile("" ::: "memory"); }
}
__device__ __forceinline__ void pool_phase(const Args& a, const Frame& F, int l) {
    const bf16_t* proj = (const bf16_t*)(a.ws + WS_PROJ); const bf16_t* WPT = (const bf16_t*)(a.ws + WS_WPT); bf16_t* AB = (bf16_t*)(a.ws + WS_XN);
    const float* psc = a.pool_scale + (size_t)l * 512;
    const int NGW = F.G * 8, fr = F.lane & 15, fq = F.lane >> 4;
    const int ntb = (l == 0 ? MTOT : MLAT) / 16, nitems = 4 * ntb;
    LAS bf16_t* WPL = (LAS bf16_t*)F.lds;
    LAS bf16_t* ROWS = WPL + 128 * LDP;
    int cur_g = -1;
    for (int it0 = F.bid * 8; it0 < nitems; it0 += NGW) {
        const int g = it0 / ntb, tb0 = it0 - g * ntb, row0b = tb0 * 16;
        int seqbase, N;
        if (row0b < MLAT) { seqbase = row0b & ~(SEQ - 1); N = SEQ; } else { seqbase = MLAT + ((row0b - MLAT) & ~(CTXL - 1)); N = CTXL; }
        const int T0 = row0b - seqbase;
        __syncthreads();
        if (g != cur_g) {
            for (int o = F.tid; o < 128 * 16; o += 512) { const int r = o >> 4, c16 = o & 15; *(LAS u32x4*)(WPL + r * LDP + c16 * 8) = *(const u32x4*)(WPT + (size_t)(g * 128 + r) * 128 + c16 * 8); }
            cur_g = g;
        }
        {
            u32x4 rv[5];
#pragma unroll
            for (int k = 0; k < 5; ++k) { const int u = F.tid + k * 512, r = u >> 4, c16 = u & 15, tt = T0 - 8 + r;
                rv[k] = (u < 144 * 16 && tt >= 0 && tt < N) ? *(const u32x4*)(proj + (size_t)(seqbase + tt) * INW + OFF_PX + g * 128 + c16 * 8) : (u32x4){0u, 0u, 0u, 0u}; }
#pragma unroll
            for (int k = 0; k < 5; ++k) { const int u = F.tid + k * 512, r = u >> 4, c16 = u & 15; if (u < 144 * 16) *(LAS u32x4*)(ROWS + r * LDP + c16 * 8) = rv[k]; }
        }
        __syncthreads();
        const int it = it0 + F.wave;
        if (it >= nitems) continue;
        const int row0 = row0b + F.wave * 16, t = T0 + F.wave * 16 + fr, tl = 8 + F.wave * 16 + fr;
        if (g == 0) pool_item<0>(proj, WPL, ROWS, AB, psc, row0, t, N, tl, fr, fq);
        else if (g == 1) pool_item<1>(proj, WPL, ROWS, AB, psc, row0, t, N, tl, fr, fq);
        else if (g == 2) pool_item<2>(proj, WPL, ROWS, AB, psc, row0, t, N, tl, fr, fq);
        else pool_item<3>(proj, WPL, ROWS, AB, psc, row0, t, N, tl, fr, fq);
    }
    __syncthreads();
}

__device__ __forceinline__ void scan_phase(const Args& a, const Frame& F, int l) {
    const bf16_t* KVT = (const bf16_t*)(a.ws + WS_KVT); bf16_t* SST = (bf16_t*)(a.ws + WS_SST); const float* LG = (const float*)(a.ws + WS_LG) + l * 16;
    const int gt = F.bid * 512 + F.tid, NT = F.G * 512;
    for (int o = gt; o < 32 * 2 * 128 * 16; o += NT) {
        const int d8 = o & 15, e = (o >> 4) & 127, dir = (o >> 11) & 1, bh = o >> 12, h = bh & 7;
        const float dec = __expf(LG[dir * 8 + h] * (float)CH);
        float s[8];
#pragma unroll
        for (int q = 0; q < 8; ++q) s[q] = 0.f;
        for (int st0 = 0; st0 < NCH; st0 += 17) {
            u32x4 kvr[17]; size_t offs[17];
#pragma unroll
            for (int q = 0; q < 17; ++q) { const int st = st0 + q; const int cc = (dir == 0) ? st : ((st < NCH_C) ? (NCH_C - 1 - st) : (NCH - 1 - (st - NCH_C)));
                offs[q] = ((size_t)(bh * NCH + cc) * 2 + dir) * 16384 + e * 128 + d8 * 8; kvr[q] = *(const u32x4*)(KVT + offs[q]); }
#pragma unroll
            for (int q = 0; q < 17; ++q) { *(u32x4*)(SST + offs[q]) = pack8(s); float kv[8]; unpack8(kvr[q], kv);
#pragma unroll
                for (int z = 0; z < 8; ++z) s[z] = dec * s[z] + kv[z]; }
        }
    }
}

__device__ __forceinline__ void fourier2(const Args& a, const Frame& F, int l) {
    const bf16_t* proj = (const bf16_t*)(a.ws + WS_PROJ); const bf16_t* A3 = (const bf16_t*)(a.ws + WS_A3); const bf16_t* TP = (const bf16_t*)(a.ws + WS_TP);
    const bf16_t* WCST = (const bf16_t*)(a.ws + WS_WCST); bf16_t* AB = (bf16_t*)(a.ws + WS_XN);
    const int gw = F.bid * 8 + F.wave, NGW = F.G * 8, fr = F.lane & 15, fq = F.lane >> 4;
    const int nlat = 4 * 64 * 4 * 4, nitems = nlat + (l == 0 ? 4 * 4 * 4 * 4 : 0);
    LAS bf16_t* WCL = (LAS bf16_t*)F.lds;
    LAS bf16_t* TPL = (LAS bf16_t*)(F.lds + 65536);
    int cur_g = -1;
    for (int it0 = F.bid * 8; it0 < nitems; it0 += NGW) {
        const int it = it0 + F.wave;
        const int gblk = (it0 < nlat) ? ((it0 >> 8) & 3) : ((it0 - nlat) >> 6);
        __syncthreads();
        if (gblk != cur_g) {
            for (int o = F.tid; o < 4096; o += 512) *(LAS u32x4*)(WCL + o * 8) = *(const u32x4*)(WCST + (size_t)gblk * 32768 + (size_t)o * 8);
            cur_g = gblk;
        }
        {
            u32x4 tv[8];
#pragma unroll
            for (int k = 0; k < 8; ++k) { const int u = F.tid + k * 512, q = u >> 11, row = (u >> 4) & 127, c16 = u & 15; const int itq = it0 + 4 * q;
                const bf16_t* tq;
                if (itq < nlat) tq = TP + ((size_t)((itq >> 10) * 64 + ((itq >> 2) & 63)) * 512 + ((itq >> 8) & 3) * 128) * 128;
                else { const int i2 = itq - nlat; tq = TP + TP_CTX_OFF + ((size_t)(((i2 >> 4) & 3) * 4 + ((i2 >> 2) & 3)) * 512 + (i2 >> 6) * 128) * 128; }
                tv[k] = (itq < nitems) ? *(const u32x4*)(tq + (size_t)row * 128 + c16 * 8) : (u32x4){0u, 0u, 0u, 0u}; }
#pragma unroll
            for (int k = 0; k < 8; ++k) { const int u = F.tid + k * 512, q = u >> 11, row = (u >> 4) & 127, c16 = u & 15; *(LAS u32x4*)(TPL + (q * 128 + row) * LDP + c16 * 8) = tv[k]; }
        }
        __syncthreads();
        if (it >= nitems) continue;
        int mb, g, m1, s, NM1, seqbase;
        if (it < nlat) { mb = it & 3; m1 = (it >> 2) & 63; g = (it >> 8) & 3; s = it >> 10; NM1 = 64; seqbase = s * SEQ; }
        else { const int i2 = it - nlat; mb = i2 & 3; m1 = (i2 >> 2) & 3; s = (i2 >> 4) & 3; g = i2 >> 6; NM1 = 4; seqbase = MLAT + s * CTXL; }
        const LAS bf16_t* tpl = TPL + (F.wave >> 2) * 128 * LDP;
        f32x4 accY[8][2];
#pragma unroll
        for (int cbk = 0; cbk < 8; ++cbk) { accY[cbk][0] = (f32x4){0.f, 0.f, 0.f, 0.f}; accY[cbk][1] = (f32x4){0.f, 0.f, 0.f, 0.f}; }
#pragma unroll
        for (int ks = 0; ks < 4; ++ks) {
            const bf16x8 b0 = *(const bf16x8*)(A3 + (mb * 16 + fr) * 128 + ks * 32 + fq * 8), b1 = *(const bf16x8*)(A3 + (64 + mb * 16 + fr) * 128 + ks * 32 + fq * 8);
#pragma unroll
            for (int cbk = 0; cbk < 8; ++cbk) { const bf16x8 av = *(const LAS bf16x8*)(tpl + (cbk * 16 + fr) * LDP + ks * 32 + fq * 8);
                accY[cbk][0] = mfma16(av, b0, accY[cbk][0]); accY[cbk][1] = mfma16(av, b1, accY[cbk][1]); }
        }
        f32x4 acc2[8];
#pragma unroll
        for (int dt = 0; dt < 8; ++dt) acc2[dt] = (f32x4){0.f, 0.f, 0.f, 0.f};
#pragma unroll
        for (int cbk = 0; cbk < 8; ++cbk) {
            u32x4 w; w.x = pk2(accY[cbk][0][0], accY[cbk][0][1]); w.y = pk2(accY[cbk][0][2], accY[cbk][0][3]); w.z = pk2(accY[cbk][1][0], accY[cbk][1][1]); w.w = pk2(accY[cbk][1][2], accY[cbk][1][3]);
            const bf16x8 f2 = as_bf16x8(w);
#pragma unroll
            for (int dt = 0; dt < 8; ++dt) { const bf16x8 wv = *(const LAS bf16x8*)(WCL + ((cbk * 128 + dt * 16 + fr) * 4 + fq) * 8); acc2[dt] = mfma16(wv, f2, acc2[dt]); }
        }
        const size_t row = (size_t)(seqbase + m1 + NM1 * (mb * 16 + fr));
        u32x2 gv[8];
#pragma unroll
        for (int dt = 0; dt < 8; ++dt) gv[dt] = *(const u32x2*)(proj + row * INW + OFF_FG + g * 128 + dt * 16 + fq * 4);
#pragma unroll
        for (int dt = 0; dt < 8; ++dt) { u32x2 o; o.x = pk2(acc2[dt][0] * bflo(gv[dt].x), acc2[dt][1] * bfhi(gv[dt].x)); o.y = pk2(acc2[dt][2] * bflo(gv[dt].y), acc2[dt][3] * bfhi(gv[dt].y));
            *(u32x2*)(AB + row * LDX + g * 128 + dt * 16 + fq * 4) = o; }
        asm volatile("" ::: "memory");
    }
    __syncthreads();
}

__device__ __forceinline__ bf16x8 scale_frag(bf16x8 q, float s) {
    const u32x4 v = __builtin_bit_cast(u32x4, q); float f[8]; unpack8(v, f);
#pragma unroll
    for (int e = 0; e < 8; ++e) f[e] *= s;
    return as_bf16x8(pack8(f));
}
__device__ __forceinline__ void retout_phase(const Args& a, const Frame& F, int l, int mode, int skipwg) {
    const bf16_t* KVT = (const bf16_t*)(a.ws + WS_KVT);
    const bf16_t* proj = (const bf16_t*)(a.ws + WS_PROJ); const bf16_t* SST = (const bf16_t*)(a.ws + WS_SST); bf16_t* AB = (bf16_t*)(a.ws + WS_XN);
    const float* LG = (const float*)(a.ws + WS_LG) + l * 16;
    LAS bf16_t* KS = (LAS bf16_t*)F.lds; LAS bf16_t* VT = KS + 128 * LDP; LAS bf16_t* SF = VT + 128 * LDP; LAS bf16_t* SB = SF + 128 * LDP;
    const int fr = F.lane & 15, fq = F.lane >> 4, w = F.wave;
    const int widx = (mode == 2) ? F.bid - skipwg : F.bid, nwk = (mode == 2) ? F.G - skipwg : F.G, nv = (mode == 1) ? 32 * NCH_C : 32 * NCH_L;
    if (widx < 0) return;
    for (int v = widx; v < nv; v += nwk) {
        const int it = (mode == 1) ? ((v >> 1) * NCH + (v & 1)) : ((v >> 5) * NCH + NCH_C + (v & 31));
        int b, h, cc, rowbase, posbase; bool is_lat; chunk_decode(it, b, h, cc, rowbase, is_lat, posbase);
        const float lgf = LG[h], lgb = LG[8 + h];
        const int i = w * 16 + fr;
        {
            u32x4 kreg[4], sfreg[4], sbreg[4], vreg[4];
            const bf16_t* stf = SST + (size_t)it * 2 * 16384; const bf16_t* stb = stf + 16384; bool zf = false, zb = false;
            if (mode == 1) { stf = KVT + (size_t)(it - 1) * 2 * 16384; stb = KVT + (size_t)(it + 1) * 2 * 16384 + 16384; zf = (cc == 0); zb = (cc == 1); }
            const u32x4 zero4 = {0u, 0u, 0u, 0u};
#pragma unroll
            for (int q = 0; q < 4; ++q) { const int u = F.tid + q * 512, row = u >> 4, c16 = u & 15;
                kreg[q] = *(const u32x4*)(proj + (size_t)(rowbase + row) * INW + OFF_K + h * DK + c16 * 8);
                sfreg[q] = zf ? zero4 : *(const u32x4*)(stf + row * 128 + c16 * 8); sbreg[q] = zb ? zero4 : *(const u32x4*)(stb + row * 128 + c16 * 8); }
#pragma unroll
            for (int q = 0; q < 4; ++q) { const int u = F.tid + q * 512, j = u & 127, e8 = (u >> 7) * 8;
                vreg[q] = *(const u32x4*)(proj + (size_t)(rowbase + j) * INW + OFF_V + h * DK + e8); }
#pragma unroll
            for (int q = 0; q < 4; ++q) { const int u = F.tid + q * 512, row = u >> 4, c16 = u & 15;
                *(LAS u32x4*)(KS + row * LDP + c16 * 8) = kreg[q]; *(LAS u32x4*)(SF + row * LDP + c16 * 8) = sfreg[q]; *(LAS u32x4*)(SB + row * LDP + c16 * 8) = sbreg[q]; }
#pragma unroll
            for (int q = 0; q < 4; ++q) { const int u = F.tid + q * 512, j = u & 127, e8 = (u >> 7) * 8; const u32x4 v = vreg[q];
                LAS bf16_t* p = VT + e8 * LDP + j;
                p[0 * LDP] = (bf16_t)(v.x & 0xffff); p[1 * LDP] = (bf16_t)(v.x >> 16); p[2 * LDP] = (bf16_t)(v.y & 0xffff); p[3 * LDP] = (bf16_t)(v.y >> 16);
                p[4 * LDP] = (bf16_t)(v.z & 0xffff); p[5 * LDP] = (bf16_t)(v.z >> 16); p[6 * LDP] = (bf16_t)(v.w & 0xffff); p[7 * LDP] = (bf16_t)(v.w >> 16); }
        }
        bf16x8 qf[4];
#pragma unroll
        for (int ks = 0; ks < 4; ++ks) qf[ks] = *(const bf16x8*)(proj + (size_t)(rowbase + i) * INW + OFF_Q + h * DK + ks * 32 + fq * 8);
        __syncthreads();
        f32x4 accS[8];
#pragma unroll
        for (int jt = 0; jt < 8; ++jt) { accS[jt] = (f32x4){0.f, 0.f, 0.f, 0.f};
#pragma unroll
            for (int ks = 0; ks < 4; ++ks) { const bf16x8 kf = *(const LAS bf16x8*)(KS + (jt * 16 + fr) * LDP + ks * 32 + fq * 8); accS[jt] = mfma16(kf, qf[ks], accS[jt]); }
            if (jt & 1) asm volatile("" ::: "memory"); }
        const float l2f = lgf * 1.4426950408889634f, l2b = lgb * 1.4426950408889634f;
#pragma unroll
        for (int jt = 0; jt < 8; ++jt)
#pragma unroll
            for (int r = 0; r < 4; ++r) { const int j = jt * 16 + fq * 4 + r, dl = i - j;
                const float dv = dl > 0 ? exp2f((float)dl * l2f) : (dl < 0 ? exp2f((float)(-dl) * l2b) : 2.0f); accS[jt][r] *= dv; }
        f32x4 accO[8];
#pragma unroll
        for (int et = 0; et < 8; ++et) accO[et] = (f32x4){0.f, 0.f, 0.f, 0.f};
#pragma unroll
        for (int kb = 0; kb < 4; ++kb) {
            u32x4 pw; pw.x = pk2(accS[2 * kb][0], accS[2 * kb][1]); pw.y = pk2(accS[2 * kb][2], accS[2 * kb][3]); pw.z = pk2(accS[2 * kb + 1][0], accS[2 * kb + 1][1]); pw.w = pk2(accS[2 * kb + 1][2], accS[2 * kb + 1][3]);
            const bf16x8 pf = as_bf16x8(pw);
#pragma unroll
            for (int et = 0; et < 8; ++et) { const LAS bf16_t* vp = VT + (et * 16 + fr) * LDP + kb * 32 + fq * 4;
                const u32x2 lo = *(const LAS u32x2*)vp, hi = *(const LAS u32x2*)(vp + 16);
                u32x4 vv; vv.x = lo.x; vv.y = lo.y; vv.z = hi.x; vv.w = hi.y;
                accO[et] = mfma16(as_bf16x8(vv), pf, accO[et]); }
            asm volatile("" ::: "memory");
        }
        const float sf = __expf(lgf * (float)(i + 1)), sb = __expf(lgb * (float)(CH - i));
#pragma unroll
        for (int dir = 0; dir < 2; ++dir) {
            const LAS bf16_t* st = dir ? SB : SF;
#pragma unroll
            for (int ks = 0; ks < 4; ++ks) { const bf16x8 qs = scale_frag(qf[ks], dir ? sb : sf);
#pragma unroll
                for (int et = 0; et < 8; ++et) { const bf16x8 sv = *(const LAS bf16x8*)(st + (et * 16 + fr) * LDP + ks * 32 + fq * 8); accO[et] = mfma16(sv, qs, accO[et]); }
                asm volatile("" ::: "memory"); }
        }
        float ss = 0.f;
#pragma unroll
        for (int et = 0; et < 8; ++et) ss += (accO[et][0] * accO[et][0] + accO[et][1] * accO[et][1]) + (accO[et][2] * accO[et][2] + accO[et][3] * accO[et][3]);
        ss += __shfl_xor(ss, 16); ss += __shfl_xor(ss, 32);
        const float rinv = 1.0f / sqrtf(ss * (1.0f / 128.0f) + EPS);
        const size_t row = (size_t)(rowbase + i);
        u32x2 gv[8];
#pragma unroll
        for (int et = 0; et < 8; ++et) gv[et] = *(const u32x2*)(proj + row * INW + OFF_RG + h * DK + et * 16 + fq * 4);
#pragma unroll
        for (int et = 0; et < 8; ++et) { const int e = h * DK + et * 16 + fq * 4;
            u32x2 o; o.x = pk2(accO[et][0] * rinv * bflo(gv[et].x), accO[et][1] * rinv * bfhi(gv[et].x)); o.y = pk2(accO[et][2] * rinv * bflo(gv[et].y), accO[et][3] * rinv * bfhi(gv[et].y));
            *(u32x2*)(AB + row * LDX + 1024 + e) = o; }
        __syncthreads();
    }
}

__device__ __forceinline__ void final_norm(const Args& a, const Frame& F) {
    const int gw = F.bid * 8 + F.wave, NGW = F.G * 8;
    const bf16_t* xb = (const bf16_t*)(a.ws + WS_XFIN);
    u32x4 nx[4];
    if (gw < MLAT) {
#pragma unroll
        for (int j = 0; j < 4; ++j) nx[j] = *(const u32x4*)(xb + (size_t)gw * D + (j * 64 + F.lane) * 8); }
    for (int m = gw; m < MLAT; m += NGW) {
        float v[4][8]; float s = 0.f;
#pragma unroll
        for (int j = 0; j < 4; ++j) { unpack8(nx[j], v[j]);
#pragma unroll
            for (int e = 0; e < 8; ++e) s += v[j][e] * v[j][e]; }
        const int m2 = m + NGW;
        if (m2 < MLAT) {
#pragma unroll
            for (int j = 0; j < 4; ++j) nx[j] = *(const u32x4*)(xb + (size_t)m2 * D + (j * 64 + F.lane) * 8); }
#pragma unroll
        for (int o = 1; o < 64; o <<= 1) s += __shfl_xor(s, o);
        const float r = 1.0f / sqrtf(s * (1.0f / D) + EPS);
#pragma unroll
        for (int j = 0; j < 4; ++j) { const int col = (j * 64 + F.lane) * 8;
#pragma unroll
            for (int hh = 0; hh < 2; ++hh) { const f32x4 g = *(const f32x4*)(a.final_g + col + 4 * hh); f32x4 o;
#pragma unroll
                for (int e = 0; e < 4; ++e) o[e] = (v[j][4 * hh + e] * r) * g[e];
                *(f32x4*)(a.out + (size_t)m * D + col + 4 * hh) = o; } }
    }
}

#define XB_TMO      128
#define XB_XCNT(j)  (256  + 64 * (j))
#define XB_XSUB(j)  (1280 + 64 * (j))
#define XB_XGEN(j)  (2304 + 64 * (j))
#define XB_TOP      3328
#define XB_TOPGEN   3392
#define XCD_BAR_WORDS 3456
#define XB_SPIN_CAP (1u << 18)
__device__ __forceinline__ unsigned xb_ld(unsigned* p)              { return __hip_atomic_load(p, __ATOMIC_RELAXED, __HIP_MEMORY_SCOPE_AGENT); }
__device__ __forceinline__ unsigned xb_add(unsigned* p, unsigned v) { return __hip_atomic_fetch_add(p, v, __ATOMIC_RELAXED, __HIP_MEMORY_SCOPE_AGENT); }
__device__ __forceinline__ unsigned xb_xcc_id() { return (unsigned)__builtin_amdgcn_s_getreg((3 << 11) | 20) & 0xFu; }
#define XB_SPIN(cond, bar) do { unsigned _sp = 0; while (cond) { __builtin_amdgcn_s_sleep(1); \
    if ((++_sp & 255u) == 0u) { if (xb_ld(&(bar)[XB_TMO])) break; if (_sp > XB_SPIN_CAP) { atomicAdd(&(bar)[XB_TMO], 1u); break; } } } } while (0)
struct XcdBarrier { unsigned* bar; unsigned x; volatile LAS unsigned* st; };
__device__ __forceinline__ XcdBarrier xcd_barrier_post(unsigned* bar, volatile LAS unsigned* st) {
    XcdBarrier b; b.bar = bar; b.x = xb_xcc_id(); b.st = st;
    if (threadIdx.x == 0) (void)xb_add(&bar[XB_XCNT(b.x)], 1u);
    return b;
}
__device__ __forceinline__ void xcd_barrier_complete(unsigned* bar, unsigned x, unsigned& nloc, unsigned& nx) {
    const unsigned G = gridDim.x * gridDim.y * gridDim.z;
    unsigned sum, cnt, mine, sp = 0u;
    for (;;) {
        sum = 0u; cnt = 0u; mine = 0u;
#pragma unroll
        for (unsigned j = 0; j < 16; ++j) { const unsigned c = xb_ld(&bar[XB_XCNT(j)]); sum += c; cnt += (c > 0u) ? 1u : 0u; mine = (j == x) ? c : mine; }
        if (sum == G) break;
        __builtin_amdgcn_s_sleep(1);
        if ((++sp & 255u) == 0u) { if (xb_ld(&bar[XB_TMO])) break; if (sp > XB_SPIN_CAP) { atomicAdd(&bar[XB_TMO], 1u); break; } }
    }
    nloc = mine > 0u ? mine : 1u; nx = cnt > 0u ? cnt : 1u;
}
__device__ __forceinline__ void xcd_barrier(unsigned* bar_, volatile LAS unsigned* st_) {
    XcdBarrier b; b.bar = bar_; b.st = st_; b.x = xb_xcc_id();
    asm volatile("s_waitcnt vmcnt(0)" ::: "memory");
    __syncthreads();
    if (threadIdx.x == 0) {
        unsigned* bar = b.bar;
        __builtin_amdgcn_s_waitcnt(0);
        unsigned nloc = b.st[0], nx = b.st[1];
        if (nloc == 0u) { xcd_barrier_complete(bar, b.x, nloc, nx); b.st[0] = nloc; b.st[1] = nx; }
        const unsigned old = xb_add(&bar[XB_XSUB(b.x)], 1u);
        const unsigned gen = old / nloc;
        if (old + 1u == (gen + 1u) * nloc) {
            __builtin_amdgcn_fence(__ATOMIC_RELEASE, "agent");
            asm volatile("s_waitcnt vmcnt(0)" ::: "memory");
            const unsigned og = xb_add(&bar[XB_TOP], 1u);
            const unsigned tg = og / nx;
            if (og + 1u == (tg + 1u) * nx) xb_add(&bar[XB_TOPGEN], 1u);
            else XB_SPIN(xb_ld(&bar[XB_TOPGEN]) == tg, bar);
            __builtin_amdgcn_fence(__ATOMIC_ACQUIRE, "agent");
            xb_add(&bar[XB_XGEN(b.x)], 1u);
            asm volatile("s_waitcnt vmcnt(0)" ::: "memory");
        } else {
            XB_SPIN(xb_ld(&bar[XB_XGEN(b.x)]) == gen, bar);
            __builtin_amdgcn_fence(__ATOMIC_ACQUIRE, "agent");
            asm volatile("s_waitcnt vmcnt(0)" ::: "memory");
        }
    }
    __syncthreads();
}

constexpr int NPHASE = 16;
__global__ void __launch_bounds__(512, 2) fwd_mega(const float* p_x, const float* p_c, const float* p_ctx, const float* p_cctx, const float* p_wada, const float* p_bada, const float* p_ng,
        const float* p_win, const float* p_wf, const float* p_wp, const float* p_ps, const float* p_dl, const float* p_wuf, const float* p_wup, const float* p_wur, const float* p_wout,
        const float* p_fg, float* p_out, unsigned char* p_ws, int ph_lo, int ph_hi) {
    Args a{p_x, p_c, p_ctx, p_cctx, p_wada, p_bada, p_ng, p_win, p_wf, p_wp, p_ps, p_dl, p_wuf, p_wup, p_wur, p_wout, p_fg, p_out, p_ws, ph_lo, ph_hi};
    extern __shared__ __attribute__((aligned(16))) unsigned char lds_raw[];
    cg::grid_group grid = cg::this_grid();
    Frame F; F.lds = (LAS unsigned char*)lds_raw; F.tid = threadIdx.x; F.lane = F.tid & 63; F.wave = __builtin_amdgcn_readfirstlane(F.tid >> 6); F.G = gridDim.x; F.bid = blockIdx.x;
#define REFRAME() do { int _t = threadIdx.x; asm volatile("" : "+v"(_t)); { unsigned long long _z = 0; asm volatile("" : "+s"(_z)); a.ws = p_ws + _z; } F.tid = _t; F.lane = _t & 63; F.wave = __builtin_amdgcn_readfirstlane(_t >> 6); } while (0)
    const int lo = a.ph_lo, hi = a.ph_hi;
    volatile LAS unsigned* xst = (volatile LAS unsigned*)(F.lds + LDS_BYTES - 64);
    if (F.tid < 4) xst[F.tid] = 0u;
    __syncthreads();
    (void)xcd_barrier_post((unsigned*)(a.ws + WS_BAR), xst);
#define IN(k) (lo <= (k) && (k) < hi)
#define SEAM(k) do { if (IN(k) && IN((k) + 1)) { if (lo < 0) grid.sync(); else xcd_barrier((unsigned*)(a.ws + WS_BAR), (volatile LAS unsigned*)(F.lds + LDS_BYTES - 64)); } } while (0)
    if (IN(0)) {
#ifndef NO_P0
        p0_mod(a, F); REFRAME(); p0_misc(a, F); REFRAME(); weights_layer(a, F, 0, 31, F.bid, F.G);
#endif
    }
    SEAM(0);
    for (int l = 0; l < DEPTH; ++l) {
        const int p = 1 + 7 * l;
        if (IN(p)) {
#ifndef NO_PA
            REFRAME(); if (l == 0) prenorm(a, F, l, 0); else { prenorm_b16(a, F, l); REFRAME(); prenorm(a, F, l, MLAT); } if (l == 1) { __syncthreads(); REFRAME(); weights_layer(a, F, 1, 31, F.bid, F.G); }
#endif
        }
        SEAM(p);
        if (IN(p + 1)) {
#ifndef NO_PB
            pg8::Gemm g{(const bf16_t*)(a.ws + WS_XN), (const bf16_t*)(a.ws + WS_WIN), LDX, LDX, MTOT, INW, D};
            pg8::StaticOrder S;
            if (l == DEPTH - 1) { S.init(MLAT, INW, F.G, F.bid, WGM_IN); S.add_extra(MLAT / 256, OFF_K / 256, (MCTX / 256) * ((OFF_RG - OFF_K) / 256)); }
            else S.init(MTOT, INW, F.G, F.bid, WGM_IN);
            pg8::EpiInProj E{(bf16_t*)(a.ws + WS_PROJ)};
            pg8::gemm_phase<pg8::EpiInProj>(F.lds, g, S, E);
#endif
        }
        SEAM(p + 1);
        if (IN(p + 2)) {
#ifndef NO_KV
            REFRAME(); kv_phase(a, F, l);
#endif
#ifndef NO_F1
            REFRAME(); fourier1(a, F, l);
#endif
#ifndef NO_POOL
            REFRAME(); pool_phase(a, F, l);
#endif
        }
        SEAM(p + 2);
        if (IN(p + 3)) {
#ifndef NO_SCAN
            REFRAME(); scan_phase(a, F, l);
#endif
#ifndef NO_F2
            REFRAME(); fourier2(a, F, l);
#endif
#ifndef NO_RO
            if (l == 0) { REFRAME(); retout_phase(a, F, l, 1, 0); }
#endif
        }
        SEAM(p + 3);
        constexpr int NCTXU = (MCTX / 256) * (D / 256);
        const bool split = (l == 0) && (F.G >= 4 * NCTXU);
        if (IN(p + 4)) {
#ifndef NO_RO
            if (split && F.bid < NCTXU) {
                pg8::Gemm g{(const bf16_t*)(a.ws + WS_XN) + (size_t)MLAT * LDX, (const bf16_t*)(a.ws + WS_WUP), LDX, LDX, MCTX, D, D};
                pg8::StaticOrder S; S.init(MCTX, D, NCTXU, F.bid, 4);
                pg8::EpiUp E{(const bf16_t*)(a.ws + WS_PROJ) + (size_t)MLAT * INW, (bf16_t*)(a.ws + WS_MERGED) + (size_t)MLAT * LDX};
                pg8::gemm_phase<pg8::EpiUp>(F.lds, g, S, E);
            } else { REFRAME(); retout_phase(a, F, l, split ? 2 : 0, NCTXU); }
#endif
        }
        SEAM(p + 4);
        const int Mrows = (l == 0) ? MTOT : MLAT;
        if (IN(p + 5)) {
#ifndef NO_PF
            const int Mup = split ? MLAT : Mrows;
            pg8::Gemm g{(const bf16_t*)(a.ws + WS_XN), (const bf16_t*)(a.ws + WS_WUP), LDX, LDX, Mup, D, D};
            pg8::StaticOrder S; S.init(Mup, D, F.G, F.bid, WGM_UP);
            pg8::EpiUp E{(const bf16_t*)(a.ws + WS_PROJ), (bf16_t*)(a.ws + WS_MERGED)};
            pg8::gemm_phase<pg8::EpiUp>(F.lds, g, S, E);
#endif
        }
        SEAM(p + 5);
        if (IN(p + 6)) {
#ifndef NO_PG
            pg8::Gemm g{(const bf16_t*)(a.ws + WS_MERGED), (const bf16_t*)(a.ws + WS_WOUT), LDX, LDX, Mrows, D, D};
            pg8::StaticOrder S; S.init(Mrows, D, F.G, F.bid, WGM_OUT);
            pg8::EpiOut E{(l == 0) ? a.x : nullptr, (l == 0) ? nullptr : (const bf16_t*)a.out, (l == DEPTH - 1) ? (bf16_t*)(a.ws + WS_XFIN) : (bf16_t*)a.out, a.ctx, (float*)(a.ws + WS_CTX1),
                          (const float*)(a.ws + WS_MOD) + (size_t)l * 5 * 6144};
            pg8::gemm_phase<pg8::EpiOut>(F.lds, g, S, E);
#endif
        }
        SEAM(p + 6);
    }
    if (IN(15)) { REFRAME(); final_norm(a, F); }
#undef IN
#undef SEAM
}

extern "C" void kernel_launch(void* const* d_in, const int* in_sizes, int n_in, void* d_out, int out_size, void* d_ws, size_t ws_size, hipStream_t stream) {
    static int grid = 0;
    if (grid == 0) {
        if (n_in != 17 || out_size != MLAT * D || ws_size < WS_END) { fprintf(stderr, "kernel_launch: unexpected shapes: n_in %d out %d ws %zu (need >= %zu)\n", n_in, out_size, ws_size, (size_t)WS_END); grid = -1; return; }
        int dev = 0, cus = 0, per_cu = 0;
        if (hipGetDevice(&dev) != hipSuccess || hipDeviceGetAttribute(&cus, hipDeviceAttributeMultiprocessorCount, dev) != hipSuccess) { grid = -1; return; }
        if (hipFuncSetAttribute((const void*)fwd_mega, hipFuncAttributeMaxDynamicSharedMemorySize, LDS_BYTES) != hipSuccess) { fprintf(stderr, "kernel_launch: hipFuncSetAttribute failed\n"); grid = -1; return; }
        if (hipOccupancyMaxActiveBlocksPerMultiprocessor(&per_cu, (const void*)fwd_mega, 512, LDS_BYTES) != hipSuccess || per_cu < 1) { fprintf(stderr, "kernel_launch: occupancy query gave %d\n", per_cu); (void)hipGetLastError(); grid = -1; return; }
        grid = cus * per_cu;
        fprintf(stderr, "kernel_launch: grid %d (cus %d x %d)\n", grid, cus, per_cu);
    }
    if (grid < 0) return;
    Args a{};
    a.x = (const float*)d_in[0]; a.c = (const float*)d_in[1]; a.ctx = (const float*)d_in[2]; a.c_ctx = (const float*)d_in[3]; a.w_ada = (const float*)d_in[4]; a.b_ada = (const float*)d_in[5];
    a.norm_g = (const float*)d_in[6]; a.w_in = (const float*)d_in[7]; a.w_fourier = (const float*)d_in[8]; a.w_pool = (const float*)d_in[9]; a.pool_scale = (const float*)d_in[10];
    a.decay_logit = (const float*)d_in[11]; a.w_up_f = (const float*)d_in[12]; a.w_up_p = (const float*)d_in[13]; a.w_up_r = (const float*)d_in[14]; a.w_out = (const float*)d_in[15];
    a.final_g = (const float*)d_in[16]; a.out = (float*)d_out; a.ws = (unsigned char*)d_ws;
    a.ph_lo = 0; a.ph_hi = NPHASE;
    if (hipMemsetAsync((unsigned char*)d_ws + WS_BAR, 0, XCD_BAR_WORDS * 4, stream) != hipSuccess) { fprintf(stderr, "kernel_launch: memset failed\n"); return; }
    void* args[] = {&a.x, &a.c, &a.ctx, &a.c_ctx, &a.w_ada, &a.b_ada, &a.norm_g, &a.w_in, &a.w_fourier, &a.w_pool, &a.pool_scale, &a.decay_logit, &a.w_up_f, &a.w_up_p, &a.w_up_r, &a.w_out,
                    &a.final_g, &a.out, &a.ws, &a.ph_lo, &a.ph_hi};
    hipError_t e = hipLaunchCooperativeKernel((const void*)fwd_mega, dim3(grid), dim3(512), args, LDS_BYTES, stream);
    if (e != hipSuccess) fprintf(stderr, "kernel_launch: cooperative launch failed: %s (grid %d)\n", hipGetErrorString(e), grid);
}
```

```cpp
#include <hip/hip_runtime.h>
#include <hip/hip_cooperative_groups.h>
#include <cstdio>
#include <cstdint>
namespace cg = cooperative_groups;

#define LAS __attribute__((address_space(3)))
typedef unsigned short bf16_t;
typedef short bf16x8 __attribute__((ext_vector_type(8)));
typedef float f32x4 __attribute__((ext_vector_type(4)));
typedef float f32x2 __attribute__((ext_vector_type(2)));
typedef unsigned u32x4 __attribute__((ext_vector_type(4)));
typedef unsigned u32x2 __attribute__((ext_vector_type(2)));

constexpr int D = 2048, NB = 4, SEQ = 4096, CTXL = 256, DEPTH = 2;
constexpr int MLAT = NB * SEQ, MCTX = NB * CTXL, MTOT = MLAT + MCTX;
constexpr int INW = 12288;
constexpr int LDX = 2048 + 64;
constexpr int OFF_FX = 0, OFF_FG = 512, OFF_PX = 1024, OFF_PG = 1536, OFF_Q = 2048, OFF_K = 3072, OFF_V = 4096, OFF_RG = 5120, OFF_MG = 6144;
constexpr int NH = 8, DK = 128, CH = 128;
constexpr int NCH_L = SEQ / CH, NCH_C = CTXL / CH, NCH = NCH_L + NCH_C;
constexpr float EPS = 1e-6f;
constexpr float TWO_PI = 6.283185307179586f;

constexpr size_t MiB = 1u << 20;
constexpr size_t WS_MOD = 0;
constexpr size_t WS_LG = 248 * 1024;
constexpr size_t WS_WCST = 256 * 1024;
constexpr size_t WS_WPT = 512 * 1024;
constexpr size_t WS_A1 = 640 * 1024;
constexpr size_t WS_A3 = 656 * 1024;
constexpr size_t WS_BAR = 704 * 1024;
constexpr size_t WS_WIN = 1 * MiB;
constexpr size_t WS_WUP = 51 * MiB;
constexpr size_t WS_WOUT = 60 * MiB;
constexpr size_t WS_XN = 69 * MiB;
constexpr size_t WS_PROJ = 140 * MiB;
constexpr size_t WS_XFIN = WS_PROJ;
constexpr size_t WS_CTX1 = 548 * MiB;
constexpr size_t WS_KVT = 556 * MiB;
constexpr size_t WS_MERGED = WS_KVT;
constexpr size_t WS_SST = 627 * MiB;
constexpr size_t WS_TP = 695 * MiB;
constexpr size_t WS_END = 730 * MiB;
static_assert(WS_WIN + (size_t)12288 * LDX * 2 <= WS_WUP && WS_WUP + (size_t)2048 * LDX * 2 <= WS_WOUT && WS_WOUT + (size_t)2048 * LDX * 2 <= WS_XN && WS_XN + (size_t)MTOT * LDX * 2 <= WS_PROJ
              && WS_PROJ + (size_t)MTOT * INW * 2 <= WS_CTX1 && WS_MERGED + (size_t)MTOT * LDX * 2 <= WS_SST && WS_KVT + (size_t)32 * 34 * 2 * 16384 * 2 <= WS_SST && WS_SST + (size_t)32 * 34 * 2 * 16384 * 2 <= WS_TP
              && WS_TP + ((size_t)4 * 64 * 512 * 128 + (size_t)4 * 4 * 512 * 128) * 2 <= WS_END, "d_ws map");
constexpr size_t TP_CTX_OFF = (size_t)4 * 64 * 512 * 128;

constexpr int LDS_BYTES = 147456;
constexpr int WGM_IN = 4, WGM_UP = 4, WGM_OUT = 4;

__device__ __forceinline__ unsigned f2bf(float f) { unsigned u = __float_as_uint(f); return (u + 0x7fffu + ((u >> 16) & 1u)) >> 16; }
__device__ __forceinline__ unsigned pk2(float lo, float hi) { return f2bf(lo) | (f2bf(hi) << 16); }
__device__ __forceinline__ float bflo(unsigned w) { return __uint_as_float(w << 16); }
__device__ __forceinline__ float bfhi(unsigned w) { return __uint_as_float(w & 0xffff0000u); }
__device__ __forceinline__ float bf2f(bf16_t b) { return __uint_as_float(((unsigned)b) << 16); }
__device__ __forceinline__ unsigned cvt_pk_bf16(float lo, float hi) { unsigned r; asm volatile("v_cvt_pk_bf16_f32 %0, %1, %2" : "=v"(r) : "v"(lo), "v"(hi)); return r; }
__device__ __forceinline__ float sigmoidf_(float x) { return __builtin_amdgcn_rcpf(1.0f + __expf(-x)); }
__device__ __forceinline__ f32x4 mfma16(bf16x8 a, bf16x8 b, f32x4 c) { return __builtin_amdgcn_mfma_f32_16x16x32_bf16(a, b, c, 0, 0, 0); }
__device__ __forceinline__ bf16x8 as_bf16x8(u32x4 v) { return __builtin_bit_cast(bf16x8, v); }
__device__ __forceinline__ float sin_rev(float r) { return __builtin_amdgcn_sinf(r); }
__device__ __forceinline__ float cos_rev(float r) { return __builtin_amdgcn_cosf(r); }
#define LDS_WAIT() asm volatile("s_waitcnt lgkmcnt(0)" ::: "memory")
__device__ __forceinline__ void unpack8(const u32x4 v, float (&f)[8]) {
    f[0] = bflo(v.x); f[1] = bfhi(v.x); f[2] = bflo(v.y); f[3] = bfhi(v.y); f[4] = bflo(v.z); f[5] = bfhi(v.z); f[6] = bflo(v.w); f[7] = bfhi(v.w);
}
__device__ __forceinline__ u32x4 pack8(const float (&f)[8]) { u32x4 w; w.x = pk2(f[0], f[1]); w.y = pk2(f[2], f[3]); w.z = pk2(f[4], f[5]); w.w = pk2(f[6], f[7]); return w; }
__device__ __forceinline__ unsigned off_b(unsigned row, unsigned ch) { return 256u * row + 16u * (ch ^ (((row & 3) << 2) | ((row >> 2) & 3))); }
__device__ __forceinline__ unsigned tr_addr(unsigned base_row, unsigned c, unsigned lane) { const unsigned q = (lane & 15) >> 2, p = lane & 3; return off_b(base_row + q, 2 * c + (p >> 1)) + 8 * (p & 1); }
__device__ __forceinline__ void tr_read8(unsigned a0, unsigned a1, u32x2 (&r)[2][4]) {
    asm volatile("ds_read_b64_tr_b16 %0, %8\n\tds_read_b64_tr_b16 %1, %8 offset:8192\n\tds_read_b64_tr_b16 %2, %8 offset:16384\n\tds_read_b64_tr_b16 %3, %8 offset:24576\n\t"
                 "ds_read_b64_tr_b16 %4, %9\n\tds_read_b64_tr_b16 %5, %9 offset:8192\n\tds_read_b64_tr_b16 %6, %9 offset:16384\n\tds_read_b64_tr_b16 %7, %9 offset:24576\n\ts_waitcnt lgkmcnt(0)"
                 : "=&v"(r[0][0]), "=&v"(r[0][1]), "=&v"(r[0][2]), "=&v"(r[0][3]), "=&v"(r[1][0]), "=&v"(r[1][1]), "=&v"(r[1][2]), "=&v"(r[1][3]) : "v"(a0), "v"(a1) : "memory");
}

namespace pg8 {
constexpr int BM = 256, BK = 64, HALF = 128, HTB = HALF * BK * 2, STAGE_BYTES = 8 * HTB, NXCD = 8;
__device__ __forceinline__ int lds_byte(int r, int c) { const int st = (r >> 4) * 2 + (c >> 5), rr = r & 15, cc = c & 31, ob = rr * 64 + cc * 2; return st * 1024 + (ob ^ (((ob >> 9) & 1) << 5)); }
__device__ __forceinline__ void stage_rc(int b, int& R, int& C) { const int st = b / 1024, sb = b % 1024, swz = sb ^ (((sb >> 9) & 1) << 5); R = (st >> 1) * 16 + swz / 64; C = (st & 1) * 32 + (swz % 64) / 2; }
__device__ __forceinline__ int perm32(int rho) { const int n = rho >> 4, i = rho & 15; return 8 * (i >> 2) + 4 * n + (i & 3); }

struct Unit { int pm, pn; };
struct Gemm { const bf16_t* A; const bf16_t* Bt; int lda, ldb, M, N, K; };

struct StaticOrder {
    int nM, nN, nwg, G, c, WGM, xpm, xpn, xn;
    __device__ void init(int M, int N, int G_, int c_, int wgm) { nM = M / BM; nN = N / BM; nwg = nM * nN; G = G_; c = c_; WGM = wgm; xn = 0; xpm = 0; xpn = 0; }
    __device__ void add_extra(int pm0, int pn0, int n) { xpm = pm0; xpn = pn0; xn = n; }
    __device__ bool next(int i, Unit& u) const {
        const long L = (long)i * G + c;
        if (L >= nwg) { const int e = (int)(L - nwg); if (e >= xn) return false; u.pm = xpm + (e & 3); u.pn = xpn + (e >> 2); return true; }
        int wgid = (int)L; { const int q = nwg / NXCD, r = nwg % NXCD, xcd = wgid % NXCD, off = wgid / NXCD; wgid = (xcd < r ? xcd * (q + 1) : r * (q + 1) + (xcd - r) * q) + off; }
        const int nig = WGM * nN, gid = wgid / nig, fm = gid * WGM, gsz = (nM - fm) < WGM ? (nM - fm) : WGM;
        u.pm = fm + ((wgid % nig) % gsz); u.pn = (wgid % nig) / gsz; return true;
    }
};

template <class Epi>
__device__ __forceinline__ void gemm_phase(LAS unsigned char* lds, const Gemm g, const StaticOrder& S, const Epi& E) {
    int tid = threadIdx.x; asm volatile("" : "+v"(tid));
    const int wid = __builtin_amdgcn_readfirstlane(tid >> 6), lane = tid & 63, wr = wid >> 2, wc = wid & 3, fr = lane & 15, fq = lane >> 4;
    const int K = g.K, nt = K / BK;
    unsigned voffA[2], voffB[2];
#pragma unroll
    for (int i = 0; i < 2; ++i) { int R, C; stage_rc(tid * 16 + i * 8192, R, C); const int Rb = Epi::PERM ? ((R & ~31) + perm32(R & 31)) : R;
        voffA[i] = (unsigned)(R * g.lda + C) * 2u; voffB[i] = (unsigned)(Rb * g.ldb + C) * 2u; }
    const size_t kstep = (size_t)(BK * 2);
    const size_t hstepA = (size_t)HALF * g.lda * 2, hstepB = (size_t)HALF * g.ldb * 2;
    const size_t tstepA = 2 * hstepA, tstepB = 2 * hstepB;
    const unsigned ldsw = (unsigned)wid * 1024u;
    const int aoff = lds_byte(wr * 64 + fr, fq * 8), boff = lds_byte(wc * 32 + fr, fq * 8);
#define PG8_SA(b, h) (((b) * 2 + (h)) * HTB)
#define PG8_SB(b, h) ((4 + (b) * 2 + (h)) * HTB)
#define PG8_STAGE(bufoff, gbase, voff) do { _Pragma("unroll") for (int _i = 0; _i < 2; ++_i) \
        __builtin_amdgcn_global_load_lds((const unsigned*)((const char*)(gbase) + (voff)[_i]), (LAS unsigned*)(lds + (bufoff) + ldsw + _i * 8192), 16, 0, 0); } while (0)
#define PG8_LDA(dst, b, h) do { _Pragma("unroll") for (int m = 0; m < 4; ++m) _Pragma("unroll") for (int k = 0; k < 2; ++k) dst[m][k] = *(const LAS bf16x8*)(lds + PG8_SA(b, h) + aoff + m * 2048 + k * 1024); } while (0)
#define PG8_LDB(dst, b, h) do { _Pragma("unroll") for (int n = 0; n < 2; ++n) _Pragma("unroll") for (int k = 0; k < 2; ++k) dst[n][k] = *(const LAS bf16x8*)(lds + PG8_SB(b, h) + boff + n * 2048 + k * 1024); } while (0)
#define PG8_MMA(ai, bj, At, Bt) do { __builtin_amdgcn_s_setprio(1); _Pragma("unroll") for (int m = 0; m < 4; ++m) _Pragma("unroll") for (int n = 0; n < 2; ++n) _Pragma("unroll") for (int k = 0; k < 2; ++k) \
        acc[ai][bj][m][n] = __builtin_amdgcn_mfma_f32_16x16x32_bf16(Bt[n][k], At[m][k], acc[ai][bj][m][n], 0, 0, 0); __builtin_amdgcn_s_setprio(0); } while (0)
#define PG8_WAIT_V(n) asm volatile("s_waitcnt vmcnt(" #n ")" ::: "memory")
#define PG8_WAIT_L(n) asm volatile("s_waitcnt lgkmcnt(" #n ")" ::: "memory")
#define PG8_BAR __builtin_amdgcn_s_barrier()
#define PG8_SCHED __builtin_amdgcn_sched_barrier(0)
    Unit cur, nxt; int ui = 0;
    if (!S.next(0, cur)) return;
    f32x4 acc[2][2][4][2];
#pragma unroll
    for (int a = 0; a < 2; ++a)
#pragma unroll
        for (int b = 0; b < 2; ++b)
#pragma unroll
            for (int m = 0; m < 4; ++m)
#pragma unroll
                for (int n = 0; n < 2; ++n) acc[a][b][m][n] = (f32x4){0.f, 0.f, 0.f, 0.f};
    bf16x8 At[4][2], B0[2][2], B1[2][2];
    const char* cA = (const char*)g.A + (size_t)cur.pm * tstepA; const char* cB = (const char*)g.Bt + (size_t)cur.pn * tstepB;
    PG8_STAGE(PG8_SB(0, 0), cB, voffB); PG8_STAGE(PG8_SB(0, 1), cB + hstepB, voffB); PG8_STAGE(PG8_SA(0, 0), cA, voffA); PG8_STAGE(PG8_SA(0, 1), cA + hstepA, voffA);
    if (wr == 1) PG8_BAR;
    PG8_WAIT_V(2); PG8_BAR;
    PG8_STAGE(PG8_SB(1, 0), cB + kstep, voffB); PG8_STAGE(PG8_SA(1, 0), cA + kstep, voffA); PG8_STAGE(PG8_SB(1, 1), cB + hstepB + kstep, voffB);
    PG8_WAIT_V(6); PG8_BAR;
    for (;;) {
        const bool has_next = S.next(ui + 1, nxt);
        const char* nA = has_next ? (const char*)g.A + (size_t)nxt.pm * tstepA : cA; const char* nB = has_next ? (const char*)g.Bt + (size_t)nxt.pn * tstepB : cB;
#pragma unroll 1
        for (int seg = 0; seg < (Epi::MIDK ? 3 : 1); ++seg) {
        const int t0 = Epi::MIDK ? seg * 8 : 0, t1 = Epi::MIDK ? (seg == 2 ? nt : seg * 8 + 8) : nt;
        if constexpr (Epi::MIDK) { if (seg > 0) { PG8_SCHED;
            asm volatile("s_cmp_lg_u32 %0, 0\n\ts_cbranch_scc1 1f\n\ts_barrier\n1:" :: "s"(wr) : "memory", "scc");
            E.mid(acc, cur, t0, wr, wc, fr, fq);
            asm volatile("s_cmp_lg_u32 %0, 1\n\ts_cbranch_scc1 1f\n\ts_barrier\n1:" :: "s"(wr) : "memory", "scc");
            PG8_SCHED; } }
#pragma unroll 1
        for (int t = t0; t < t1; t += 2) {
            const bool last = (t == nt - 2);
            const char* a1 = cA + (size_t)(t + 1) * kstep;
            const char* a2 = last ? nA : cA + (size_t)(t + 2) * kstep; const char* b2 = last ? nB : cB + (size_t)(t + 2) * kstep;
            const char* a3 = a2 + kstep; const char* b3 = b2 + kstep;
            PG8_LDB(B0, 0, 0); PG8_LDB(B1, 0, 1); PG8_SCHED; PG8_LDA(At, 0, 0); PG8_STAGE(PG8_SA(1, 1), a1 + hstepA, voffA);
            PG8_WAIT_V(8); PG8_WAIT_L(0); PG8_BAR; PG8_MMA(0, 0, At, B0); PG8_MMA(0, 1, At, B1); PG8_BAR; PG8_SCHED;
            PG8_LDA(At, 0, 1); PG8_STAGE(PG8_SB(0, 0), b2, voffB); PG8_STAGE(PG8_SB(0, 1), b2 + hstepB, voffB); PG8_STAGE(PG8_SA(0, 0), a2, voffA);
            PG8_WAIT_V(8); PG8_WAIT_L(0); PG8_BAR; PG8_MMA(1, 0, At, B0); PG8_MMA(1, 1, At, B1); PG8_BAR; PG8_SCHED;
            PG8_LDB(B0, 1, 0); PG8_LDB(B1, 1, 1); PG8_SCHED; PG8_LDA(At, 1, 0); PG8_STAGE(PG8_SA(0, 1), a2 + hstepA, voffA);
            PG8_WAIT_V(8); PG8_WAIT_L(0); PG8_BAR; PG8_MMA(0, 0, At, B0); PG8_MMA(0, 1, At, B1); PG8_BAR; PG8_SCHED;
            PG8_LDA(At, 1, 1); PG8_STAGE(PG8_SB(1, 0), b3, voffB); PG8_STAGE(PG8_SB(1, 1), b3 + hstepB, voffB); PG8_STAGE(PG8_SA(1, 0), a3, voffA);
            PG8_WAIT_V(8); PG8_WAIT_L(0); PG8_BAR; PG8_MMA(1, 0, At, B0); PG8_MMA(1, 1, At, B1); PG8_BAR; PG8_SCHED;
        }
        }
        if (wr == 0) PG8_BAR;
        E(acc, cur, wr, wc, fr, fq);
        if (!has_next) break;
#pragma unroll
        for (int a = 0; a < 2; ++a)
#pragma unroll
            for (int b = 0; b < 2; ++b)
#pragma unroll
                for (int m = 0; m < 4; ++m)
#pragma unroll
                    for (int n = 0; n < 2; ++n) acc[a][b][m][n] = (f32x4){0.f, 0.f, 0.f, 0.f};
        cur = nxt; cA = nA; cB = nB; ++ui;
        if (wr == 1) PG8_BAR;
    }
    PG8_WAIT_V(0);
    PG8_BAR;
#undef PG8_SA
#undef PG8_SB
#undef PG8_STAGE
#undef PG8_LDA
#undef PG8_LDB
#undef PG8_MMA
#undef PG8_WAIT_V
#undef PG8_WAIT_L
#undef PG8_BAR
#undef PG8_SCHED
}

struct EpiInProj {
    static constexpr bool PERM = true, MIDK = false;
    bf16_t* O;
    __device__ __forceinline__ void mid(f32x4 (&)[2][2][4][2], const Unit&, int, int, int, int, int) const {}
    __device__ __forceinline__ void operator()(const f32x4 (&acc)[2][2][4][2], const Unit& u, int wr, int wc, int fr, int fq) const {
        const int pn = u.pn;
        int act = 0;
        if (pn >= 24) act = 2; else if ((pn >= 2 && pn < 4) || (pn >= 6 && pn < 8) || (pn >= 20)) act = 1; else if (pn >= 8 && pn < 12) act = 3;
        int row0 = u.pm * BM + wr * 64 + fr, col0 = pn * BM + wc * 32 + 8 * fq; asm volatile("" : "+v"(row0), "+v"(col0));
#pragma unroll
        for (int ai = 0; ai < 2; ++ai)
#pragma unroll
            for (int m = 0; m < 4; ++m) { bf16_t* rowp = O + (size_t)(row0 + ai * HALF + m * 16) * INW + col0;
#pragma unroll
                for (int bj = 0; bj < 2; ++bj) { f32x4 v0 = acc[ai][bj][m][0], v1 = acc[ai][bj][m][1];
                    if (act == 1) {
#pragma unroll
                        for (int j = 0; j < 4; ++j) { v0[j] = v0[j] * sigmoidf_(v0[j]); v1[j] = v1[j] * sigmoidf_(v1[j]); } }
                    else if (act == 2) {
#pragma unroll
                        for (int j = 0; j < 4; ++j) { v0[j] = sigmoidf_(v0[j]); v1[j] = sigmoidf_(v1[j]); } }
                    else if (act == 3) { v0 = v0 * 0.08838834764831845f; v1 = v1 * 0.08838834764831845f; }
                    u32x4 w; w.x = cvt_pk_bf16(v0[0], v0[1]); w.y = cvt_pk_bf16(v0[2], v0[3]); w.z = cvt_pk_bf16(v1[0], v1[1]); w.w = cvt_pk_bf16(v1[2], v1[3]);
                    *(u32x4*)(rowp + bj * HALF) = w; } }
    }
};

struct EpiUp {
    static constexpr bool PERM = true, MIDK = true;
    const bf16_t* P;
    bf16_t* O;
    __device__ __forceinline__ void mid(f32x4 (&acc)[2][2][4][2], const Unit& u, int t, int wr, int wc, int fr, int fq) const {
        const int br = (t == 8) ? 0 : 1;
        int row0 = u.pm * BM + wr * 64 + fr, col0 = u.pn * BM + wc * 32 + 8 * fq; asm volatile("" : "+v"(row0), "+v"(col0));
#pragma unroll
        for (int ai = 0; ai < 2; ++ai) {
            u32x4 ga[4][2], gb[4][2];
#pragma unroll
            for (int m = 0; m < 4; ++m) { const bf16_t* gp = P + (size_t)(row0 + ai * HALF + m * 16) * INW + OFF_MG + br * 2048 + col0;
#pragma unroll
                for (int bj = 0; bj < 2; ++bj) { ga[m][bj] = *(const u32x4*)(gp + bj * HALF); gb[m][bj] = *(const u32x4*)(gp + 2048 + bj * HALF); } }
#pragma unroll
            for (int m = 0; m < 4; ++m)
#pragma unroll
                for (int bj = 0; bj < 2; ++bj) { const u32x4 a_ = ga[m][bj], b_ = gb[m][bj];
                    f32x4 r0, r1;
                    r0[0] = bflo(a_.x) * __builtin_amdgcn_rcpf(bflo(b_.x)); r0[1] = bfhi(a_.x) * __builtin_amdgcn_rcpf(bfhi(b_.x));
                    r0[2] = bflo(a_.y) * __builtin_amdgcn_rcpf(bflo(b_.y)); r0[3] = bfhi(a_.y) * __builtin_amdgcn_rcpf(bfhi(b_.y));
                    r1[0] = bflo(a_.z) * __builtin_amdgcn_rcpf(bflo(b_.z)); r1[1] = bfhi(a_.z) * __builtin_amdgcn_rcpf(bfhi(b_.z));
                    r1[2] = bflo(a_.w) * __builtin_amdgcn_rcpf(bflo(b_.w)); r1[3] = bfhi(a_.w) * __builtin_amdgcn_rcpf(bfhi(b_.w));
                    acc[ai][bj][m][0] = acc[ai][bj][m][0] * r0; acc[ai][bj][m][1] = acc[ai][bj][m][1] * r1; }
            asm volatile("" ::: "memory"); }
    }
    __device__ __forceinline__ void operator()(const f32x4 (&acc)[2][2][4][2], const Unit& u, int wr, int wc, int fr, int fq) const {
        int row0 = u.pm * BM + wr * 64 + fr, col0 = u.pn * BM + wc * 32 + 8 * fq; asm volatile("" : "+v"(row0), "+v"(col0));
#pragma unroll
        for (int ai = 0; ai < 2; ++ai) {
            u32x4 gc[4][2];
#pragma unroll
            for (int m = 0; m < 4; ++m) { const bf16_t* gp = P + (size_t)(row0 + ai * HALF + m * 16) * INW + OFF_MG + 2 * 2048 + col0;
#pragma unroll
                for (int bj = 0; bj < 2; ++bj) gc[m][bj] = *(const u32x4*)(gp + bj * HALF); }
#pragma unroll
            for (int m = 0; m < 4; ++m) { bf16_t* rowp = O + (size_t)(row0 + ai * HALF + m * 16) * LDX + col0;
#pragma unroll
                for (int bj = 0; bj < 2; ++bj) { const u32x4 g_ = gc[m][bj];
                    const f32x4 v0 = acc[ai][bj][m][0], v1 = acc[ai][bj][m][1];
                    u32x4 w; w.x = cvt_pk_bf16(v0[0] * bflo(g_.x), v0[1] * bfhi(g_.x)); w.y = cvt_pk_bf16(v0[2] * bflo(g_.y), v0[3] * bfhi(g_.y));
                    w.z = cvt_pk_bf16(v1[0] * bflo(g_.z), v1[1] * bfhi(g_.z)); w.w = cvt_pk_bf16(v1[2] * bflo(g_.w), v1[3] * bfhi(g_.w));
                    *(u32x4*)(rowp + bj * HALF) = w; } }
            asm volatile("" ::: "memory"); }
    }
};

struct EpiOut {
    static constexpr bool PERM = true, MIDK = false;
    const float* xold_f32; const bf16_t* xold_b16; bf16_t* xnew_b16; const float* xold_ctx; float* xnew_ctx; const float* mod;
    __device__ __forceinline__ void mid(f32x4 (&)[2][2][4][2], const Unit&, int, int, int, int, int) const {}
    __device__ __forceinline__ void operator()(const f32x4 (&acc)[2][2][4][2], const Unit& u, int wr, int wc, int fr, int fq) const {
        const bool isctx = u.pm >= (MLAT / BM);
        const int mrow = isctx ? 4 : (u.pm >> 4);
        int row0 = u.pm * BM + wr * 64 + fr, col0 = u.pn * BM + wc * 32 + 8 * fq; asm volatile("" : "+v"(row0), "+v"(col0));
        f32x4 gv[2][2];
#pragma unroll
        for (int bj = 0; bj < 2; ++bj)
#pragma unroll
            for (int n = 0; n < 2; ++n) gv[bj][n] = *(const f32x4*)(mod + mrow * 6144 + 4096 + col0 + bj * HALF + n * 4);
        if (isctx) {
            const float* xo = xold_ctx - (size_t)MLAT * D; float* xn = xnew_ctx - (size_t)MLAT * D;
#pragma unroll
            for (int am = 0; am < 4; ++am) {
                const int ai = am >> 1, mb = (am & 1) * 2;
                f32x4 xv[2][2][2];
#pragma unroll
                for (int mm = 0; mm < 2; ++mm) { const size_t off = (size_t)(row0 + ai * HALF + (mb + mm) * 16) * D + col0;
#pragma unroll
                    for (int bj = 0; bj < 2; ++bj)
#pragma unroll
                        for (int n = 0; n < 2; ++n) xv[mm][bj][n] = *(const f32x4*)(xo + off + bj * HALF + n * 4); }
#pragma unroll
                for (int mm = 0; mm < 2; ++mm) { const size_t off = (size_t)(row0 + ai * HALF + (mb + mm) * 16) * D + col0;
#pragma unroll
                    for (int bj = 0; bj < 2; ++bj)
#pragma unroll
                        for (int n = 0; n < 2; ++n) *(f32x4*)(xn + off + bj * HALF + n * 4) = xv[mm][bj][n] + gv[bj][n] * acc[ai][bj][mb + mm][n]; }
                asm volatile("" ::: "memory"); }
        } else if (xold_b16) {
#pragma unroll
            for (int ai = 0; ai < 2; ++ai) {
                u32x4 xb[4][2];
#pragma unroll
                for (int m = 0; m < 4; ++m) { const size_t off = (size_t)(row0 + ai * HALF + m * 16) * D + col0;
#pragma unroll
                    for (int bj = 0; bj < 2; ++bj) xb[m][bj] = *(const u32x4*)(xold_b16 + off + bj * HALF); }
#pragma unroll
                for (int m = 0; m < 4; ++m) { const size_t off = (size_t)(row0 + ai * HALF + m * 16) * D + col0;
#pragma unroll
                    for (int bj = 0; bj < 2; ++bj) { const u32x4 x_ = xb[m][bj]; const f32x4 a0 = acc[ai][bj][m][0], a1 = acc[ai][bj][m][1], g0 = gv[bj][0], g1 = gv[bj][1];
                        u32x4 w; w.x = cvt_pk_bf16(bflo(x_.x) + g0[0] * a0[0], bfhi(x_.x) + g0[1] * a0[1]); w.y = cvt_pk_bf16(bflo(x_.y) + g0[2] * a0[2], bfhi(x_.y) + g0[3] * a0[3]);
                        w.z = cvt_pk_bf16(bflo(x_.z) + g1[0] * a1[0], bfhi(x_.z) + g1[1] * a1[1]); w.w = cvt_pk_bf16(bflo(x_.w) + g1[2] * a1[2], bfhi(x_.w) + g1[3] * a1[3]);
                        *(u32x4*)(xnew_b16 + off + bj * HALF) = w; } }
                asm volatile("" ::: "memory"); }
        } else {
#pragma unroll
            for (int am = 0; am < 4; ++am) {
                const int ai = am >> 1, mb = (am & 1) * 2;
                f32x4 xv[2][2][2];
#pragma unroll
                for (int mm = 0; mm < 2; ++mm) { const size_t off = (size_t)(row0 + ai * HALF + (mb + mm) * 16) * D + col0;
#pragma unroll
                    for (int bj = 0; bj < 2; ++bj)
#pragma unroll
                        for (int n = 0; n < 2; ++n) xv[mm][bj][n] = *(const f32x4*)(xold_f32 + off + bj * HALF + n * 4); }
#pragma unroll
                for (int mm = 0; mm < 2; ++mm) { const size_t off = (size_t)(row0 + ai * HALF + (mb + mm) * 16) * D + col0;
#pragma unroll
                    for (int bj = 0; bj < 2; ++bj) { const f32x4 v0 = xv[mm][bj][0] + gv[bj][0] * acc[ai][bj][mb + mm][0], v1 = xv[mm][bj][1] + gv[bj][1] * acc[ai][bj][mb + mm][1];
                        u32x4 w; w.x = cvt_pk_bf16(v0[0], v0[1]); w.y = cvt_pk_bf16(v0[2], v0[3]); w.z = cvt_pk_bf16(v1[0], v1[1]); w.w = cvt_pk_bf16(v1[2], v1[3]);
                        *(u32x4*)(xnew_b16 + off + bj * HALF) = w; } }
                asm volatile("" ::: "memory"); }
        }
    }
};
}

struct Args {
    const float* x; const float* c; const float* ctx; const float* c_ctx; const float* w_ada; const float* b_ada; const float* norm_g; const float* w_in;
    const float* w_fourier; const float* w_pool; const float* pool_scale; const float* decay_logit; const float* w_up_f; const float* w_up_p; const float* w_up_r;
    const float* w_out; const float* final_g; float* out; unsigned char* ws;
    int ph_lo, ph_hi;
};

struct Frame {
    LAS unsigned char* lds; int tid, lane, wave, G, bid;
};

__device__ __forceinline__ void transpose_item(const float* W, int N, bf16_t* WT, int ldo, int koff, LAS float* scr, int item, int lane) {
    const int nblk = N / 64, kb = item / nblk, nb = item % nblk, k0 = 64 * kb, n0 = 64 * nb;
    float wv[64];
#pragma unroll
    for (int i = 0; i < 64; ++i) wv[i] = W[(size_t)(k0 + i) * N + n0 + lane];
#pragma unroll
    for (int i = 0; i < 64; ++i) scr[i * 65 + lane] = wv[i];
    LDS_WAIT();
    const int c = lane & 7;
#pragma unroll
    for (int j = 0; j < 8; ++j) { const int n = (lane >> 3) + 8 * j; const LAS float* s_ = scr + (8 * c) * 65 + n;
        u32x4 o; o.x = pk2(s_[0 * 65], s_[1 * 65]); o.y = pk2(s_[2 * 65], s_[3 * 65]); o.z = pk2(s_[4 * 65], s_[5 * 65]); o.w = pk2(s_[6 * 65], s_[7 * 65]);
        *(u32x4*)(WT + (size_t)(n0 + n) * ldo + koff + k0 + 8 * c) = o; }
    LDS_WAIT();
}

__device__ __forceinline__ void weights_layer(const Args& a, const Frame& F, int l, int parts, int widx, int nwk) {
    LAS float* scr = (LAS float*)(F.lds + F.wave * 16640);
    const int gw = widx * 8 + F.wave, NGW = nwk * 8;
    bf16_t* WIN = (bf16_t*)(a.ws + WS_WIN); bf16_t* WUP = (bf16_t*)(a.ws + WS_WUP); bf16_t* WOUT = (bf16_t*)(a.ws + WS_WOUT);
    constexpr int I_IN = 32 * 192, I_UF = 8 * 32, I_UP = 8 * 32, I_UR = 16 * 32, I_O = 32 * 32;
    if (parts & 1) for (int it = gw; it < I_IN / 2; it += NGW) transpose_item(a.w_in + (size_t)l * D * INW, INW, WIN, LDX, 0, scr, it, F.lane);
    if (parts & 16) for (int it = I_IN / 2 + gw; it < I_IN; it += NGW) transpose_item(a.w_in + (size_t)l * D * INW, INW, WIN, LDX, 0, scr, it, F.lane);
    if (parts & 2) for (int it = gw; it < I_UF + I_UP + I_UR; it += NGW) {
        int r = it;
        if (r < I_UF) { transpose_item(a.w_up_f + (size_t)l * 512 * D, D, WUP, LDX, 0, scr, r, F.lane); continue; } r -= I_UF;
        if (r < I_UP) { transpose_item(a.w_up_p + (size_t)l * 512 * D, D, WUP, LDX, 512, scr, r, F.lane); continue; } r -= I_UP;
        transpose_item(a.w_up_r + (size_t)l * 1024 * D, D, WUP, LDX, 1024, scr, r, F.lane);
    }
    if (parts & 4) for (int it = gw; it < I_O; it += NGW) transpose_item(a.w_out + (size_t)l * D * D, D, WOUT, LDX, 0, scr, it, F.lane);
    if (parts & 8) {
        const int gt = widx * 512 + F.tid, NT = nwk * 512;
        bf16_t* WCST = (bf16_t*)(a.ws + WS_WCST); bf16_t* WPT = (bf16_t*)(a.ws + WS_WPT);
        const float* wf = a.w_fourier + (size_t)l * 4 * 128 * 128; const float* wp = a.w_pool + (size_t)l * 4 * 128 * 128;
        for (int o = gt; o < 4 * 8 * 128 * 32; o += NT) {
            const int jj = o & 7, fq = (o >> 3) & 3, d = (o >> 5) & 127, cbk = (o >> 12) & 7, g = o >> 15;
            const int cch = cbk * 16 + fq * 4 + (jj & 3); const bool is_sin = jj >= 4;
            float s = 0.f;
            for (int dp = 0; dp < 128; ++dp) { const float rev = (float)((cch * dp) & 127) * (1.0f / 128.0f);
                const float tw = is_sin ? sin_rev(rev) : cos_rev(rev); s += tw * wf[(g * 128 + dp) * 128 + d]; }
            WCST[o] = (bf16_t)f2bf(s * 0.08838834764831845f);
        }
        for (int o = gt; o < 4 * 128 * 128; o += NT) { const int cch = o & 127, d = (o >> 7) & 127, g = o >> 14; WPT[o] = (bf16_t)f2bf(wp[(g * 128 + cch) * 128 + d]); }
    }
}

__device__ __forceinline__ void p0_misc(const Args& a, const Frame& F) {
    const int gt = F.bid * 512 + F.tid, NT = F.G * 512;
    bf16_t* A1 = (bf16_t*)(a.ws + WS_A1); bf16_t* A3 = (bf16_t*)(a.ws + WS_A3); float* LG = (float*)(a.ws + WS_LG);
    for (int o = gt; o < 128 * 64; o += NT) { const int aa = o & 63, r = o >> 6, m1 = r & 63; const float rev = (float)((m1 * aa) & 63) * (1.0f / 64.0f);
        A1[o] = (bf16_t)f2bf(r < 64 ? cos_rev(rev) : -sin_rev(rev)); }
    for (int o = gt; o < 128 * 128; o += NT) { const int k = o & 127, r = o >> 7, m2 = r & 63, n2 = k >> 1, ri = k & 1; const float rev = (float)((m2 * n2) & 63) * (1.0f / 64.0f);
        const float cs = cos_rev(rev), sn = sin_rev(rev);
        const float v = (r < 64) ? (ri == 0 ? cs : sn) : (ri == 0 ? -sn : cs);
        A3[o] = (bf16_t)f2bf(v); }
    for (int o = gt; o < 32; o += NT) { const float z = a.decay_logit[o]; LG[o] = -log1pf(expf(-z)); }
}

__device__ __forceinline__ void p0_mod(const Args& a, const Frame& F) {
    LAS float* sc = (LAS float*)F.lds;
    LAS float* red = (LAS float*)(F.lds + 5 * 2048 * 4);
    float* MOD = (float*)(a.ws + WS_MOD);
    bool have = false;
    for (int it = F.bid; it < 2 * 96; it += F.G) {
        if (!have) {
            for (int o = F.tid; o < 5 * 2048; o += 512) { const float v = (o < 4 * 2048) ? a.c[o] : a.c_ctx[o - 4 * 2048]; sc[o] = v * sigmoidf_(v); }
            have = true;
        }
        __syncthreads();
        const int l = it / 96, cg0 = (it % 96) * 64;
        const int cq = F.tid & 15, ks = F.tid >> 4;
        const float* W = a.w_ada + (size_t)l * D * 6144 + cg0 + cq * 4;
        f32x4 ac[5];
#pragma unroll
        for (int r = 0; r < 5; ++r) ac[r] = (f32x4){0.f, 0.f, 0.f, 0.f};
#pragma unroll 16
        for (int kk = 0; kk < 64; ++kk) { const int k = ks * 64 + kk; const f32x4 w = *(const f32x4*)(W + (size_t)k * 6144);
#pragma unroll
            for (int r = 0; r < 5; ++r) ac[r] += w * sc[r * 2048 + k]; }
#pragma unroll
        for (int r = 0; r < 5; ++r)
#pragma unroll
            for (int j = 0; j < 4; ++j) red[(ks * 16 + cq) * 20 + r * 4 + j] = ac[r][j];
        __syncthreads();
        if (F.tid < 320) { const int cq2 = F.tid / 20, rj = F.tid % 20, r = rj >> 2, j = rj & 3; float s = 0.f;
            for (int k2 = 0; k2 < 32; ++k2) s += red[(k2 * 16 + cq2) * 20 + rj];
            const int col = cg0 + cq2 * 4 + j;
            MOD[(l * 5 + r) * 6144 + col] = s + a.b_ada[l * 6144 + col]; }
        __syncthreads();
    }
}

__device__ __forceinline__ void prenorm_b16(const Args& a, const Frame& F, int l) {
    const int gw = F.bid * 8 + F.wave, NGW = F.G * 8;
    const float* MOD = (const float*)(a.ws + WS_MOD) + (size_t)l * 5 * 6144;
    const bf16_t* xb = (const bf16_t*)a.out; const float* ng = a.norm_g + (size_t)l * D;
    bf16_t* XN = (bf16_t*)(a.ws + WS_XN);
    u32x4 nx[4];
    if (gw < MLAT) {
#pragma unroll
        for (int j = 0; j < 4; ++j) nx[j] = *(const u32x4*)(xb + (size_t)gw * D + (j * 64 + F.lane) * 8); }
    for (int m = gw; m < MLAT; m += NGW) {
        const int mrow = m >> 12;
        float v[4][8]; float s = 0.f;
#pragma unroll
        for (int j = 0; j < 4; ++j) { unpack8(nx[j], v[j]);
#pragma unroll
            for (int e = 0; e < 8; ++e) s += v[j][e] * v[j][e]; }
        const int m2 = m + NGW;
        if (m2 < MLAT) {
#pragma unroll
            for (int j = 0; j < 4; ++j) nx[j] = *(const u32x4*)(xb + (size_t)m2 * D + (j * 64 + F.lane) * 8); }
#pragma unroll
        for (int o = 1; o < 64; o <<= 1) s += __shfl_xor(s, o);
        const float r = 1.0f / sqrtf(s * (1.0f / D) + EPS);
#pragma unroll
        for (int j = 0; j < 4; ++j) { const int col = (j * 64 + F.lane) * 8; float h[8];
#pragma unroll
            for (int hh = 0; hh < 2; ++hh) { const f32x4 g = *(const f32x4*)(ng + col + 4 * hh), sh = *(const f32x4*)(MOD + mrow * 6144 + col + 4 * hh), sc = *(const f32x4*)(MOD + mrow * 6144 + 2048 + col + 4 * hh);
#pragma unroll
                for (int e = 0; e < 4; ++e) h[4 * hh + e] = (v[j][4 * hh + e] * r) * g[e] * (sc[e] + 1.0f) + sh[e]; }
            *(u32x4*)(XN + (size_t)m * LDX + col) = pack8(h); }
    }
}
__device__ __forceinline__ void prenorm(const Args& a, const Frame& F, int l, int m_lo) {
    const int gw = m_lo + F.bid * 8 + F.wave, NGW = F.G * 8;
    const float* MOD = (const float*)(a.ws + WS_MOD) + (size_t)l * 5 * 6144;
    const float* xl = (l == 0) ? a.x : a.out; const float* xc = (l == 0) ? a.ctx : (const float*)(a.ws + WS_CTX1);
    const float* ng = a.norm_g + (size_t)l * D;
    bf16_t* XN = (bf16_t*)(a.ws + WS_XN);
    f32x4 v[8], nx[8];
    if (gw < MTOT) { const f32x4* xr = (const f32x4*)(gw >= MLAT ? xc + (size_t)(gw - MLAT) * D : xl + (size_t)gw * D) + F.lane;
#pragma unroll
        for (int j = 0; j < 8; ++j) nx[j] = xr[64 * j]; }
    for (int m = gw; m < MTOT; m += NGW) {
        const bool isctx = m >= MLAT; const int mrow = isctx ? 4 : (m >> 12);
#pragma unroll
        for (int j = 0; j < 8; ++j) v[j] = nx[j];
        const int m2 = m + NGW;
        if (m2 < MTOT) { const f32x4* xr = (const f32x4*)(m2 >= MLAT ? xc + (size_t)(m2 - MLAT) * D : xl + (size_t)m2 * D) + F.lane;
#pragma unroll
            for (int j = 0; j < 8; ++j) nx[j] = xr[64 * j]; }
        float s = 0.f;
#pragma unroll
        for (int j = 0; j < 8; ++j) s += (v[j].x * v[j].x + v[j].y * v[j].y) + (v[j].z * v[j].z + v[j].w * v[j].w);
#pragma unroll
        for (int o = 1; o < 64; o <<= 1) s += __shfl_xor(s, o);
        const float r = 1.0f / sqrtf(s * (1.0f / D) + EPS);
        const f32x4* gp = (const f32x4*)ng + F.lane; const f32x4* shp = (const f32x4*)(MOD + mrow * 6144) + F.lane; const f32x4* scp = (const f32x4*)(MOD + mrow * 6144 + 2048) + F.lane;
        u32x2* o8 = (u32x2*)(XN + (size_t)m * LDX) + F.lane;
#pragma unroll
        for (int j = 0; j < 8; ++j) { const f32x4 g = gp[64 * j], sh = shp[64 * j], sc = scp[64 * j];
            const f32x4 h = (v[j] * r) * g * (sc + 1.0f) + sh;
            u32x2 w; w.x = pk2(h.x, h.y); w.y = pk2(h.z, h.w); o8[64 * j] = w; }
    }
}

constexpr int LDP = 136;
__device__ __forceinline__ void chunk_decode(int it, int& b, int& h, int& cc, int& rowbase, bool& is_lat, int& posbase) {
    const int bh = it / NCH; cc = it % NCH; b = bh >> 3; h = bh & 7;
    if (cc < NCH_C) { is_lat = false; rowbase = MLAT + b * CTXL + cc * CH; posbase = cc * CH; }
    else { is_lat = true; rowbase = b * SEQ + (cc - NCH_C) * CH; posbase = (cc - NCH_C) * CH; }
}
__device__ __forceinline__ void load_vt(const bf16_t* proj, int rowbase, int h, LAS bf16_t* VT, int tid) {
#pragma unroll
    for (int q = 0; q < 4; ++q) { const int u = tid + q * 512, j = u & 127, e8 = (u >> 7) * 8;
        const u32x4 v = *(const u32x4*)(proj + (size_t)(rowbase + j) * INW + OFF_V + h * DK + e8);
        LAS bf16_t* p = VT + e8 * LDP + j;
        p[0 * LDP] = (bf16_t)(v.x & 0xffff); p[1 * LDP] = (bf16_t)(v.x >> 16); p[2 * LDP] = (bf16_t)(v.y & 0xffff); p[3 * LDP] = (bf16_t)(v.y >> 16);
        p[4 * LDP] = (bf16_t)(v.z & 0xffff); p[5 * LDP] = (bf16_t)(v.z >> 16); p[6 * LDP] = (bf16_t)(v.w & 0xffff); p[7 * LDP] = (bf16_t)(v.w >> 16); }
}

__device__ __forceinline__ void kv_phase(const Args& a, const Frame& F, int l, bool norope = false) {
    bf16_t* proj = (bf16_t*)(a.ws + WS_PROJ); bf16_t* KVT = (bf16_t*)(a.ws + WS_KVT); const float* LG = (const float*)(a.ws + WS_LG) + l * 16;
    LAS bf16_t* KFT = (LAS bf16_t*)F.lds; LAS bf16_t* KBT = KFT + 128 * LDP; LAS bf16_t* VT = KBT + 128 * LDP;
    const int fr = F.lane & 15, fq = F.lane >> 4;
    for (int it = F.bid; it < 32 * NCH; it += F.G) {
        int b, h, cc, rowbase, posbase; bool is_lat; chunk_decode(it, b, h, cc, rowbase, is_lat, posbase);
        if (norope) is_lat = false;
        const float lgf = LG[h], lgb = LG[8 + h];
        u32x4 kx1[2], kx2[2], qx1[2], qx2[2], vreg[4];
#pragma unroll
        for (int q = 0; q < 2; ++q) { const int u = F.tid + q * 512, j = u >> 3, sub = u & 7, base = (sub >> 2) * 64, i0 = (sub & 3) * 8;
            const bf16_t* kp = proj + (size_t)(rowbase + j) * INW + OFF_K + h * DK + base + i0; kx1[q] = *(const u32x4*)kp; kx2[q] = *(const u32x4*)(kp + 32);
            if (is_lat) { const bf16_t* qp = proj + (size_t)(rowbase + j) * INW + OFF_Q + h * DK + base + i0; qx1[q] = *(const u32x4*)qp; qx2[q] = *(const u32x4*)(qp + 32); } }
#pragma unroll
        for (int q = 0; q < 4; ++q) { const int u = F.tid + q * 512, vr = u >> 4, vc = u & 15; vreg[q] = *(const u32x4*)(proj + (size_t)(rowbase + vr) * INW + OFF_V + h * DK + vc * 8); }
#pragma unroll
        for (int q = 0; q < 2; ++q) {
            const int u = F.tid + q * 512, j = u >> 3, sub = u & 7, base = (sub >> 2) * 64, i0 = (sub & 3) * 8;
            const int n = posbase + j; const float pos = (float)(base == 0 ? (n >> 6) : (n & 63));
            float cs[8], sn[8];
#pragma unroll
            for (int e = 0; e < 8; ++e) { const float inv = exp2f(-(float)(i0 + e) * (13.287712379549449f / 32.0f)); float rev = pos * inv * 0.15915494309189535f; rev -= floorf(rev);
                cs[e] = is_lat ? cos_rev(rev) : 1.0f; sn[e] = is_lat ? sin_rev(rev) : 0.0f; }
            bf16_t* kp = proj + (size_t)(rowbase + j) * INW + OFF_K + h * DK + base + i0;
            float x1[8], x2[8], o1[8], o2[8];
            unpack8(kx1[q], x1); unpack8(kx2[q], x2);
#pragma unroll
            for (int e = 0; e < 8; ++e) { o1[e] = x1[e] * cs[e] - x2[e] * sn[e]; o2[e] = x1[e] * sn[e] + x2[e] * cs[e]; }
            if (is_lat) { *(u32x4*)kp = pack8(o1); *(u32x4*)(kp + 32) = pack8(o2); }
            const float wf = __expf(lgf * (float)(CH - 1 - j)), wb = __expf(lgb * (float)j);
#pragma unroll
            for (int e = 0; e < 8; ++e) { x1[e] = o1[e] * wf; x2[e] = o2[e] * wf; o1[e] *= wb; o2[e] *= wb; }
            {
                const unsigned c1 = (unsigned)(base + i0) >> 3, c2 = c1 + 4;
                *(LAS u32x4*)((LAS unsigned char*)KFT + off_b(j, c1)) = pack8(x1); *(LAS u32x4*)((LAS unsigned char*)KFT + off_b(j, c2)) = pack8(x2);
                *(LAS u32x4*)((LAS unsigned char*)KBT + off_b(j, c1)) = pack8(o1); *(LAS u32x4*)((LAS unsigned char*)KBT + off_b(j, c2)) = pack8(o2); }
            if (is_lat) {
                bf16_t* qp = proj + (size_t)(rowbase + j) * INW + OFF_Q + h * DK + base + i0;
                unpack8(qx1[q], x1); unpack8(qx2[q], x2);
#pragma unroll
                for (int e = 0; e < 8; ++e) { o1[e] = x1[e] * cs[e] - x2[e] * sn[e]; o2[e] = x1[e] * sn[e] + x2[e] * cs[e]; }
                *(u32x4*)qp = pack8(o1); *(u32x4*)(qp + 32) = pack8(o2);
            }
        }
#pragma unroll
        for (int q = 0; q < 4; ++q) { const int u = F.tid + q * 512, vr = u >> 4, vc = u & 15; *(LAS u32x4*)((LAS unsigned char*)VT + off_b(vr, vc)) = vreg[q]; }
        __syncthreads();
        const int dt = F.wave;
        bf16x8 aff[4], afb[4];
        {
            const unsigned t0 = tr_addr(8 * fq, dt, F.lane), t1 = tr_addr(8 * fq + 4, dt, F.lane);
            u32x2 rf[2][4], rb[2][4];
            tr_read8((unsigned)(unsigned long)KFT + t0, (unsigned)(unsigned long)KFT + t1, rf);
            tr_read8((unsigned)(unsigned long)KBT + t0, (unsigned)(unsigned long)KBT + t1, rb);
#pragma unroll
            for (int ks = 0; ks < 4; ++ks) { u32x4 w; w.x = rf[0][ks].x; w.y = rf[0][ks].y; w.z = rf[1][ks].x; w.w = rf[1][ks].y; aff[ks] = as_bf16x8(w);
                u32x4 w2; w2.x = rb[0][ks].x; w2.y = rb[0][ks].y; w2.z = rb[1][ks].x; w2.w = rb[1][ks].y; afb[ks] = as_bf16x8(w2); }
        }
        const unsigned vbase = (unsigned)(unsigned long)VT;
        bf16_t* dstf = KVT + (size_t)it * 2 * 16384; bf16_t* dstb = dstf + 16384;
#pragma unroll
        for (int et = 0; et < 8; ++et) {
            u32x2 r[2][4];
            tr_read8(vbase + tr_addr(8 * fq, et, F.lane), vbase + tr_addr(8 * fq + 4, et, F.lane), r);
            f32x4 accf = (f32x4){0.f, 0.f, 0.f, 0.f}, accb = (f32x4){0.f, 0.f, 0.f, 0.f};
#pragma unroll
            for (int ks = 0; ks < 4; ++ks) { u32x4 bw; bw.x = r[0][ks].x; bw.y = r[0][ks].y; bw.z = r[1][ks].x; bw.w = r[1][ks].y; const bf16x8 bv = as_bf16x8(bw);
                accf = mfma16(aff[ks], bv, accf); accb = mfma16(afb[ks], bv, accb); }
            u32x2 wf; wf.x = pk2(accf[0], accf[1]); wf.y = pk2(accf[2], accf[3]); *(u32x2*)(dstf + (et * 16 + fr) * 128 + dt * 16 + fq * 4) = wf;
            u32x2 wb; wb.x = pk2(accb[0], accb[1]); wb.y = pk2(accb[2], accb[3]); *(u32x2*)(dstb + (et * 16 + fr) * 128 + dt * 16 + fq * 4) = wb;
        }
        __syncthreads();
    }
}

__device__ __forceinline__ void fourier1(const Args& a, const Frame& F, int l) {
    const bf16_t* proj = (const bf16_t*)(a.ws + WS_PROJ); const bf16_t* A1 = (const bf16_t*)(a.ws + WS_A1); bf16_t* TP = (bf16_t*)(a.ws + WS_TP);
    const int fr = F.lane & 15, fq = F.lane >> 4, w = F.wave;
    LAS bf16_t* XS = (LAS bf16_t*)F.lds;
    {
        bf16x8 af[8][2];
#pragma unroll
        for (int t = 0; t < 8; ++t)
#pragma unroll
            for (int ks = 0; ks < 2; ++ks) af[t][ks] = *(const bf16x8*)(A1 + (t * 16 + fr) * 64 + ks * 32 + fq * 8);
        for (int it = F.bid; it < 256; it += F.G) {
            const int cblk = it & 15, nb = (it >> 4) & 3, b = it >> 6;
            u32x4 xr[8];
#pragma unroll
            for (int q = 0; q < 8; ++q) { const int u = F.tid + q * 512, row = u >> 2, ch = u & 3, aa = row >> 4, n2l = row & 15;
                xr[q] = *(const u32x4*)(proj + (size_t)(b * SEQ + 64 * aa + nb * 16 + n2l) * INW + OFF_FX + cblk * 32 + ch * 8); }
#pragma unroll
            for (int q = 0; q < 8; ++q) { const int u = F.tid + q * 512, row = u >> 2, ch = u & 3; *(LAS u32x4*)(XS + row * 40 + ch * 8) = xr[q]; }
            __syncthreads();
            const int n2 = nb * 16 + fr;
            float tcs[4][4], tsn[4][4];
#pragma unroll
            for (int t = 0; t < 4; ++t)
#pragma unroll
                for (int r = 0; r < 4; ++r) { const int m1 = t * 16 + fq * 4 + r; const float rev = (float)((m1 * n2) & 4095) * (1.0f / 4096.0f); tcs[t][r] = cos_rev(rev) * (1.0f / 64.0f); tsn[t][r] = sin_rev(rev) * (1.0f / 64.0f); }
#pragma unroll 1
            for (int cl = 0; cl < 4; ++cl) {
                const int c = w * 4 + cl;
                bf16x8 bfrag[2];
#pragma unroll
                for (int ks = 0; ks < 2; ++ks)
#pragma unroll
                    for (int jj = 0; jj < 8; ++jj) bfrag[ks][jj] = (short)XS[((ks * 32 + fq * 8 + jj) * 16 + fr) * 40 + c];
                f32x4 acc[8];
#pragma unroll
                for (int t = 0; t < 8; ++t) { acc[t] = (f32x4){0.f, 0.f, 0.f, 0.f};
#pragma unroll
                    for (int ks = 0; ks < 2; ++ks) acc[t] = mfma16(af[t][ks], bfrag[ks], acc[t]); }
                const int cg_ = cblk * 32 + c;
#pragma unroll
                for (int t = 0; t < 4; ++t)
#pragma unroll
                    for (int r = 0; r < 4; ++r) { const int m1 = t * 16 + fq * 4 + r; const float tr = acc[t][r], ti = acc[t + 4][r];
                        *(unsigned*)(TP + ((size_t)(b * 64 + m1) * 512 + cg_) * 128 + 2 * n2) = pk2(tr * tcs[t][r] + ti * tsn[t][r], ti * tcs[t][r] - tr * tsn[t][r]); }
            }
            __syncthreads();
        }
    }
    if (l == 0) {
        const int gt = F.bid * 512 + F.tid, NT = F.G * 512;
        for (int o = gt; o < 4 * 4 * 64 * 512; o += NT) {
            const int c = o & 511, n2 = (o >> 9) & 63, m1 = (o >> 15) & 3, b = o >> 17;
            float tr = 0.f, ti = 0.f;
#pragma unroll
            for (int aa = 0; aa < 4; ++aa) { const float x = bf2f(proj[(size_t)(MLAT + b * CTXL + 64 * aa + n2) * INW + OFF_FX + c]); const float rev = (float)((m1 * aa) & 3) * 0.25f;
                tr += x * cos_rev(rev); ti -= x * sin_rev(rev); }
            const float rev = (float)((m1 * n2) & 255) * (1.0f / 256.0f); const float cs = cos_rev(rev), sn = sin_rev(rev);
            const float tr2 = (tr * cs + ti * sn) * (1.0f / 16.0f), ti2 = (ti * cs - tr * sn) * (1.0f / 16.0f);
            *(unsigned*)(TP + TP_CTX_OFF + ((size_t)(b * 4 + m1) * 512 + c) * 128 + 2 * n2) = pk2(tr2, ti2);
        }
    }
}

template <int G>
__device__ __forceinline__ void pool_item(const bf16_t* proj, const LAS bf16_t* WPL, const LAS bf16_t* ROWS, bf16_t* AB, const float* psc, int row0, int t, int N, int tl, int fr, int fq) {
    constexpr int half = 1 << G;
    const int lo = max(t - half, 0), hi = min(t + half, N); const float rc = 1.0f / (float)(hi - lo);
    bf16x8 af[4];
#pragma unroll
    for (int ks = 0; ks < 4; ++ks) {
        const LAS bf16_t* cp = ROWS + (tl - half) * LDP + ks * 32 + fq * 8;
        float s[8], me[8], f[8];
#pragma unroll
        for (int e = 0; e < 8; ++e) s[e] = 0.f;
#pragma unroll
        for (int dd = 0; dd < 2 * half; ++dd) { unpack8(*(const LAS u32x4*)(cp + dd * LDP), f);
#pragma unroll
            for (int e = 0; e < 8; ++e) s[e] += f[e]; }
        unpack8(*(const LAS u32x4*)(cp + half * LDP), me);
#pragma unroll
        for (int e = 0; e < 8; ++e) s[e] = s[e] * rc - me[e];
        af[ks] = as_bf16x8(pack8(s));
    }
    const size_t row = (size_t)(row0 + fr);
#pragma unroll
    for (int dt = 0; dt < 8; ++dt) { f32x4 acc = (f32x4){0.f, 0.f, 0.f, 0.f};
#pragma unroll
        for (int ks = 0; ks < 4; ++ks) { const bf16x8 wv = *(const LAS bf16x8*)(WPL + (dt * 16 + fr) * LDP + ks * 32 + fq * 8); acc = mfma16(wv, af[ks], acc); }
        const int d0 = G * 128 + dt * 16 + fq * 4; const f32x4 ps = *(const f32x4*)(psc + d0); const u32x2 gv = *(const u32x2*)(proj + row * INW + OFF_PG + d0);
        u32x2 o; o.x = pk2(acc[0] * ps[0] * bflo(gv.x), acc[1] * ps[1] * bfhi(gv.x)); o.y = pk2(acc[2] * ps[2] * bflo(gv.y), acc[3] * ps[3] * bfhi(gv.y));
        *(u32x2*)(AB + row * LDX + 512 + d0) = o;
        if (dt & 1) asm volatile("" ::: "memory"); }
}
__device__ __forceinline__ void pool_phase(const Args& a, const Frame& F, int l) {
    const bf16_t* proj = (const bf16_t*)(a.ws + WS_PROJ); const bf16_t* WPT = (const bf16_t*)(a.ws + WS_WPT); bf16_t* AB = (bf16_t*)(a.ws + WS_XN);
    const float* psc = a.pool_scale + (size_t)l * 512;
    const int NGW = F.G * 8, fr = F.lane & 15, fq = F.lane >> 4;
    const int ntb = (l == 0 ? MTOT : MLAT) / 16, nitems = 4 * ntb;
    LAS bf16_t* WPL = (LAS bf16_t*)F.lds;
    LAS bf16_t* ROWS = WPL + 128 * LDP;
    int cur_g = -1;
    for (int it0 = F.bid * 8; it0 < nitems; it0 += NGW) {
        const int g = it0 / ntb, tb0 = it0 - g * ntb, row0b = tb0 * 16;
        int seqbase, N;
        if (row0b < MLAT) { seqbase = row0b & ~(SEQ - 1); N = SEQ; } else { seqbase = MLAT + ((row0b - MLAT) & ~(CTXL - 1)); N = CTXL; }
        const int T0 = row0b - seqbase;
        __syncthreads();
        if (g != cur_g) {
            for (int o = F.tid; o < 128 * 16; o += 512) { const int r = o >> 4, c16 = o & 15; *(LAS u32x4*)(WPL + r * LDP + c16 * 8) = *(const u32x4*)(WPT + (size_t)(g * 128 + r) * 128 + c16 * 8); }
            cur_g = g;
        }
        {
            u32x4 rv[5];
#pragma unroll
            for (int k = 0; k < 5; ++k) { const int u = F.tid + k * 512, r = u >> 4, c16 = u & 15, tt = T0 - 8 + r;
                rv[k] = (u < 144 * 16 && tt >= 0 && tt < N) ? *(const u32x4*)(proj + (size_t)(seqbase + tt) * INW + OFF_PX + g * 128 + c16 * 8) : (u32x4){0u, 0u, 0u, 0u}; }
#pragma unroll
            for (int k = 0; k < 5; ++k) { const int u = F.tid + k * 512, r = u >> 4, c16 = u & 15; if (u < 144 * 16) *(LAS u32x4*)(ROWS + r * LDP + c16 * 8) = rv[k]; }
        }
        __syncthreads();
        const int it = it0 + F.wave;
        if (it >= nitems) continue;
        const int row0 = row0b + F.wave * 16, t = T0 + F.wave * 16 + fr, tl = 8 + F.wave * 16 + fr;
        if (g == 0) pool_item<0>(proj, WPL, ROWS, AB, psc, row0, t, N, tl, fr, fq);
        else if (g == 1) pool_item<1>(proj, WPL, ROWS, AB, psc, row0, t, N, tl, fr, fq);
        else if (g == 2) pool_item<2>(proj, WPL, ROWS, AB, psc, row0, t, N, tl, fr, fq);
        else pool_item<3>(proj, WPL, ROWS, AB, psc, row0, t, N, tl, fr, fq);
    }
    __syncthreads();
}

__device__ __forceinline__ void scan_phase(const Args& a, const Frame& F, int l) {
    const bf16_t* KVT = (const bf16_t*)(a.ws + WS_KVT); bf16_t* SST = (bf16_t*)(a.ws + WS_SST); const float* LG = (const float*)(a.ws + WS_LG) + l * 16;
    const int gt = F.bid * 512 + F.tid, NT = F.G * 512;
    for (int o = gt; o < 32 * 2 * 128 * 16; o += NT) {
        const int d8 = o & 15, e = (o >> 4) & 127, dir = (o >> 11) & 1, bh = o >> 12, h = bh & 7;
        const float dec = __expf(LG[dir * 8 + h] * (float)CH);
        float s[8];
#pragma unroll
        for (int q = 0; q < 8; ++q) s[q] = 0.f;
        for (int st0 = 0; st0 < NCH; st0 += 17) {
            u32x4 kvr[17]; size_t offs[17];
#pragma unroll
            for (int q = 0; q < 17; ++q) { const int st = st0 + q; const int cc = (dir == 0) ? st : ((st < NCH_C) ? (NCH_C - 1 - st) : (NCH - 1 - (st - NCH_C)));
                offs[q] = ((size_t)(bh * NCH + cc) * 2 + dir) * 16384 + e * 128 + d8 * 8; kvr[q] = *(const u32x4*)(KVT + offs[q]); }
#pragma unroll
            for (int q = 0; q < 17; ++q) { *(u32x4*)(SST + offs[q]) = pack8(s); float kv[8]; unpack8(kvr[q], kv);
#pragma unroll
                for (int z = 0; z < 8; ++z) s[z] = dec * s[z] + kv[z]; }
        }
    }
}

__device__ __forceinline__ void fourier2(const Args& a, const Frame& F, int l) {
    const bf16_t* proj = (const bf16_t*)(a.ws + WS_PROJ); const bf16_t* A3 = (const bf16_t*)(a.ws + WS_A3); const bf16_t* TP = (const bf16_t*)(a.ws + WS_TP);
    const bf16_t* WCST = (const bf16_t*)(a.ws + WS_WCST); bf16_t* AB = (bf16_t*)(a.ws + WS_XN);
    const int gw = F.bid * 8 + F.wave, NGW = F.G * 8, fr = F.lane & 15, fq = F.lane >> 4;
    const int nlat = 4 * 64 * 4 * 4, nitems = nlat + (l == 0 ? 4 * 4 * 4 * 4 : 0);
    LAS bf16_t* WCL = (LAS bf16_t*)F.lds;
    LAS bf16_t* TPL = (LAS bf16_t*)(F.lds + 65536);
    int cur_g = -1;
    for (int it0 = F.bid * 8; it0 < nitems; it0 += NGW) {
        const int it = it0 + F.wave;
        const int gblk = (it0 < nlat) ? ((it0 >> 8) & 3) : ((it0 - nlat) >> 6);
        __syncthreads();
        if (gblk != cur_g) {
            for (int o = F.tid; o < 4096; o += 512) *(LAS u32x4*)(WCL + o * 8) = *(const u32x4*)(WCST + (size_t)gblk * 32768 + (size_t)o * 8);
            cur_g = gblk;
        }
        {
            u32x4 tv[8];
#pragma unroll
            for (int k = 0; k < 8; ++k) { const int u = F.tid + k * 512, q = u >> 11, row = (u >> 4) & 127, c16 = u & 15; const int itq = it0 + 4 * q;
                const bf16_t* tq;
                if (itq < nlat) tq = TP + ((size_t)((itq >> 10) * 64 + ((itq >> 2) & 63)) * 512 + ((itq >> 8) & 3) * 128) * 128;
                else { const int i2 = itq - nlat; tq = TP + TP_CTX_OFF + ((size_t)(((i2 >> 4) & 3) * 4 + ((i2 >> 2) & 3)) * 512 + (i2 >> 6) * 128) * 128; }
                tv[k] = (itq < nitems) ? *(const u32x4*)(tq + (size_t)row * 128 + c16 * 8) : (u32x4){0u, 0u, 0u, 0u}; }
#pragma unroll
            for (int k = 0; k < 8; ++k) { const int u = F.tid + k * 512, q = u >> 11, row = (u >> 4) & 127, c16 = u & 15; *(LAS u32x4*)(TPL + (q * 128 + row) * LDP + c16 * 8) = tv[k]; }
        }
        __syncthreads();
        if (it >= nitems) continue;
        int mb, g, m1, s, NM1, seqbase;
        if (it < nlat) { mb = it & 3; m1 = (it >> 2) & 63; g = (it >> 8) & 3; s = it >> 10; NM1 = 64; seqbase = s * SEQ; }
        else { const int i2 = it - nlat; mb = i2 & 3; m1 = (i2 >> 2) & 3; s = (i2 >> 4) & 3; g = i2 >> 6; NM1 = 4; seqbase = MLAT + s * CTXL; }
        const LAS bf16_t* tpl = TPL + (F.wave >> 2) * 128 * LDP;
        f32x4 accY[8][2];
#pragma unroll
        for (int cbk = 0; cbk < 8; ++cbk) { accY[cbk][0] = (f32x4){0.f, 0.f, 0.f, 0.f}; accY[cbk][1] = (f32x4){0.f, 0.f, 0.f, 0.f}; }
#pragma unroll
        for (int ks = 0; ks < 4; ++ks) {
            const bf16x8 b0 = *(const bf16x8*)(A3 + (mb * 16 + fr) * 128 + ks * 32 + fq * 8), b1 = *(const bf16x8*)(A3 + (64 + mb * 16 + fr) * 128 + ks * 32 + fq * 8);
#pragma unroll
            for (int cbk = 0; cbk < 8; ++cbk) { const bf16x8 av = *(const LAS bf16x8*)(tpl + (cbk * 16 + fr) * LDP + ks * 32 + fq * 8);
                accY[cbk][0] = mfma16(av, b0, accY[cbk][0]); accY[cbk][1] = mfma16(av, b1, accY[cbk][1]); }
        }
        f32x4 acc2[8];
#pragma unroll
        for (int dt = 0; dt < 8; ++dt) acc2[dt] = (f32x4){0.f, 0.f, 0.f, 0.f};
#pragma unroll
        for (int cbk = 0; cbk < 8; ++cbk) {
            u32x4 w; w.x = pk2(accY[cbk][0][0], accY[cbk][0][1]); w.y = pk2(accY[cbk][0][2], accY[cbk][0][3]); w.z = pk2(accY[cbk][1][0], accY[cbk][1][1]); w.w = pk2(accY[cbk][1][2], accY[cbk][1][3]);
            const bf16x8 f2 = as_bf16x8(w);
#pragma unroll
            for (int dt = 0; dt < 8; ++dt) { const bf16x8 wv = *(const LAS bf16x8*)(WCL + ((cbk * 128 + dt * 16 + fr) * 4 + fq) * 8); acc2[dt] = mfma16(wv, f2, acc2[dt]); }
        }
        const size_t row = (size_t)(seqbase + m1 + NM1 * (mb * 16 + fr));
        u32x2 gv[8];
#pragma unroll
        for (int dt = 0; dt < 8; ++dt) gv[dt] = *(const u32x2*)(proj + row * INW + OFF_FG + g * 128 + dt * 16 + fq * 4);
#pragma unroll
        for (int dt = 0; dt < 8; ++dt) { u32x2 o; o.x = pk2(acc2[dt][0] * bflo(gv[dt].x), acc2[dt][1] * bfhi(gv[dt].x)); o.y = pk2(acc2[dt][2] * bflo(gv[dt].y), acc2[dt][3] * bfhi(gv[dt].y));
            *(u32x2*)(AB + row * LDX + g * 128 + dt * 16 + fq * 4) = o; }
        asm volatile("" ::: "memory");
    }
    __syncthreads();
}

__device__ __forceinline__ bf16x8 scale_frag(bf16x8 q, float s) {
    const u32x4 v = __builtin_bit_cast(u32x4, q); float f[8]; unpack8(v, f);
#pragma unroll
    for (int e = 0; e < 8; ++e) f[e] *= s;
    return as_bf16x8(pack8(f));
}
__device__ __forceinline__ void retout_phase(const Args& a, const Frame& F, int l, int mode, int skipwg) {
    const bf16_t* KVT = (const bf16_t*)(a.ws + WS_KVT);
    const bf16_t* proj = (const bf16_t*)(a.ws + WS_PROJ); const bf16_t* SST = (const bf16_t*)(a.ws + WS_SST); bf16_t* AB = (bf16_t*)(a.ws + WS_XN);
    const float* LG = (const float*)(a.ws + WS_LG) + l * 16;
    LAS bf16_t* KS = (LAS bf16_t*)F.lds; LAS bf16_t* VT = KS + 128 * LDP; LAS bf16_t* SF = VT + 128 * LDP; LAS bf16_t* SB = SF + 128 * LDP;
    const int fr = F.lane & 15, fq = F.lane >> 4, w = F.wave;
    const int widx = (mode == 2) ? F.bid - skipwg : F.bid, nwk = (mode == 2) ? F.G - skipwg : F.G, nv = (mode == 1) ? 32 * NCH_C : 32 * NCH_L;
    if (widx < 0) return;
    for (int v = widx; v < nv; v += nwk) {
        const int it = (mode == 1) ? ((v >> 1) * NCH + (v & 1)) : ((v >> 5) * NCH + NCH_C + (v & 31));
        int b, h, cc, rowbase, posbase; bool is_lat; chunk_decode(it, b, h, cc, rowbase, is_lat, posbase);
        const float lgf = LG[h], lgb = LG[8 + h];
        const int i = w * 16 + fr;
        {
            u32x4 kreg[4], sfreg[4], sbreg[4], vreg[4];
            const bf16_t* stf = SST + (size_t)it * 2 * 16384; const bf16_t* stb = stf + 16384; bool zf = false, zb = false;
            if (mode == 1) { stf = KVT + (size_t)(it - 1) * 2 * 16384; stb = KVT + (size_t)(it + 1) * 2 * 16384 + 16384; zf = (cc == 0); zb = (cc == 1); }
            const u32x4 zero4 = {0u, 0u, 0u, 0u};
#pragma unroll
            for (int q = 0; q < 4; ++q) { const int u = F.tid + q * 512, row = u >> 4, c16 = u & 15;
                kreg[q] = *(const u32x4*)(proj + (size_t)(rowbase + row) * INW + OFF_K + h * DK + c16 * 8);
                sfreg[q] = zf ? zero4 : *(const u32x4*)(stf + row * 128 + c16 * 8); sbreg[q] = zb ? zero4 : *(const u32x4*)(stb + row * 128 + c16 * 8); }
#pragma unroll
            for (int q = 0; q < 4; ++q) { const int u = F.tid + q * 512, vr = u >> 4, vc = u & 15;
                vreg[q] = *(const u32x4*)(proj + (size_t)(rowbase + vr) * INW + OFF_V + h * DK + vc * 8); }
#pragma unroll
            for (int q = 0; q < 4; ++q) { const int u = F.tid + q * 512, row = u >> 4, c16 = u & 15;
                *(LAS u32x4*)(KS + row * LDP + c16 * 8) = kreg[q]; *(LAS u32x4*)(SF + row * LDP + c16 * 8) = sfreg[q]; *(LAS u32x4*)(SB + row * LDP + c16 * 8) = sbreg[q]; }
#pragma unroll
            for (int q = 0; q < 4; ++q) { const int u = F.tid + q * 512, vr = u >> 4, vc = u & 15; *(LAS u32x4*)((LAS unsigned char*)VT + off_b(vr, vc)) = vreg[q]; }
        }
        bf16x8 qf[4];
#pragma unroll
        for (int ks = 0; ks < 4; ++ks) qf[ks] = *(const bf16x8*)(proj + (size_t)(rowbase + i) * INW + OFF_Q + h * DK + ks * 32 + fq * 8);
        __syncthreads();
        f32x4 accS[8];
#pragma unroll
        for (int jt = 0; jt < 8; ++jt) { accS[jt] = (f32x4){0.f, 0.f, 0.f, 0.f};
#pragma unroll
            for (int ks = 0; ks < 4; ++ks) { const bf16x8 kf = *(const LAS bf16x8*)(KS + (jt * 16 + fr) * LDP + ks * 32 + fq * 8); accS[jt] = mfma16(kf, qf[ks], accS[jt]); }
            if (jt & 1) asm volatile("" ::: "memory"); }
        const float l2f = lgf * 1.4426950408889634f, l2b = lgb * 1.4426950408889634f;
#pragma unroll
        for (int jt = 0; jt < 8; ++jt)
#pragma unroll
            for (int r = 0; r < 4; ++r) { const int j = jt * 16 + fq * 4 + r, dl = i - j;
                const float dv = dl > 0 ? exp2f((float)dl * l2f) : (dl < 0 ? exp2f((float)(-dl) * l2b) : 2.0f); accS[jt][r] *= dv; }
        f32x4 accO[8];
#pragma unroll
        for (int et = 0; et < 8; ++et) accO[et] = (f32x4){0.f, 0.f, 0.f, 0.f};
        bf16x8 pf[4];
#pragma unroll
        for (int kb = 0; kb < 4; ++kb) {
            u32x4 pw; pw.x = pk2(accS[2 * kb][0], accS[2 * kb][1]); pw.y = pk2(accS[2 * kb][2], accS[2 * kb][3]); pw.z = pk2(accS[2 * kb + 1][0], accS[2 * kb + 1][1]); pw.w = pk2(accS[2 * kb + 1][2], accS[2 * kb + 1][3]);
            pf[kb] = as_bf16x8(pw); }
        const unsigned vbase = (unsigned)(unsigned long)VT;
#pragma unroll
        for (int et = 0; et < 8; ++et) {
            u32x2 r[2][4];
            tr_read8(vbase + tr_addr(4 * fq, et, F.lane), vbase + tr_addr(16 + 4 * fq, et, F.lane), r);
#pragma unroll
            for (int kb = 0; kb < 4; ++kb) { u32x4 vv; vv.x = r[0][kb].x; vv.y = r[0][kb].y; vv.z = r[1][kb].x; vv.w = r[1][kb].y; accO[et] = mfma16(as_bf16x8(vv), pf[kb], accO[et]); }
        }
        const float sf = __expf(lgf * (float)(i + 1)), sb = __expf(lgb * (float)(CH - i));
#pragma unroll
        for (int dir = 0; dir < 2; ++dir) {
            const LAS bf16_t* st = dir ? SB : SF;
#pragma unroll
            for (int ks = 0; ks < 4; ++ks) { const bf16x8 qs = scale_frag(qf[ks], dir ? sb : sf);
#pragma unroll
                for (int et = 0; et < 8; ++et) { const bf16x8 sv = *(const LAS bf16x8*)(st + (et * 16 + fr) * LDP + ks * 32 + fq * 8); accO[et] = mfma16(sv, qs, accO[et]); }
                asm volatile("" ::: "memory"); }
        }
        float ss = 0.f;
#pragma unroll
        for (int et = 0; et < 8; ++et) ss += (accO[et][0] * accO[et][0] + accO[et][1] * accO[et][1]) + (accO[et][2] * accO[et][2] + accO[et][3] * accO[et][3]);
        ss += __shfl_xor(ss, 16); ss += __shfl_xor(ss, 32);
        const float rinv = 1.0f / sqrtf(ss * (1.0f / 128.0f) + EPS);
        const size_t row = (size_t)(rowbase + i);
        u32x2 gv[8];
#pragma unroll
        for (int et = 0; et < 8; ++et) gv[et] = *(const u32x2*)(proj + row * INW + OFF_RG + h * DK + et * 16 + fq * 4);
#pragma unroll
        for (int et = 0; et < 8; ++et) { const int e = h * DK + et * 16 + fq * 4;
            u32x2 o; o.x = pk2(accO[et][0] * rinv * bflo(gv[et].x), accO[et][1] * rinv * bfhi(gv[et].x)); o.y = pk2(accO[et][2] * rinv * bflo(gv[et].y), accO[et][3] * rinv * bfhi(gv[et].y));
            *(u32x2*)(AB + row * LDX + 1024 + e) = o; }
        __syncthreads();
    }
}

__device__ __forceinline__ void final_norm(const Args& a, const Frame& F) {
    const int gw = F.bid * 8 + F.wave, NGW = F.G * 8;
    const bf16_t* xb = (const bf16_t*)(a.ws + WS_XFIN);
    u32x4 nx[4];
    if (gw < MLAT) {
#pragma unroll
        for (int j = 0; j < 4; ++j) nx[j] = *(const u32x4*)(xb + (size_t)gw * D + (j * 64 + F.lane) * 8); }
    for (int m = gw; m < MLAT; m += NGW) {
        float v[4][8]; float s = 0.f;
#pragma unroll
        for (int j = 0; j < 4; ++j) { unpack8(nx[j], v[j]);
#pragma unroll
            for (int e = 0; e < 8; ++e) s += v[j][e] * v[j][e]; }
        const int m2 = m + NGW;
        if (m2 < MLAT) {
#pragma unroll
            for (int j = 0; j < 4; ++j) nx[j] = *(const u32x4*)(xb + (size_t)m2 * D + (j * 64 + F.lane) * 8); }
#pragma unroll
        for (int o = 1; o < 64; o <<= 1) s += __shfl_xor(s, o);
        const float r = 1.0f / sqrtf(s * (1.0f / D) + EPS);
#pragma unroll
        for (int j = 0; j < 4; ++j) { const int col = (j * 64 + F.lane) * 8;
#pragma unroll
            for (int hh = 0; hh < 2; ++hh) { const f32x4 g = *(const f32x4*)(a.final_g + col + 4 * hh); f32x4 o;
#pragma unroll
                for (int e = 0; e < 4; ++e) o[e] = (v[j][4 * hh + e] * r) * g[e];
                *(f32x4*)(a.out + (size_t)m * D + col + 4 * hh) = o; } }
    }
}

#define XB_TMO      128
#define XB_XCNT(j)  (256  + 64 * (j))
#define XB_XSUB(j)  (1280 + 64 * (j))
#define XB_XGEN(j)  (2304 + 64 * (j))
#define XB_TOP      3328
#define XB_TOPGEN   3392
#define XCD_BAR_WORDS 3456
#define XB_SPIN_CAP (1u << 18)
__device__ __forceinline__ unsigned xb_ld(unsigned* p)              { return __hip_atomic_load(p, __ATOMIC_RELAXED, __HIP_MEMORY_SCOPE_AGENT); }
__device__ __forceinline__ unsigned xb_add(unsigned* p, unsigned v) { return __hip_atomic_fetch_add(p, v, __ATOMIC_RELAXED, __HIP_MEMORY_SCOPE_AGENT); }
__device__ __forceinline__ unsigned xb_xcc_id() { return (unsigned)__builtin_amdgcn_s_getreg((3 << 11) | 20) & 0xFu; }
#define XB_SPIN(cond, bar) do { unsigned _sp = 0; while (cond) { __builtin_amdgcn_s_sleep(1); \
    if ((++_sp & 255u) == 0u) { if (xb_ld(&(bar)[XB_TMO])) break; if (_sp > XB_SPIN_CAP) { atomicAdd(&(bar)[XB_TMO], 1u); break; } } } } while (0)
struct XcdBarrier { unsigned* bar; unsigned x; volatile LAS unsigned* st; };
__device__ __forceinline__ XcdBarrier xcd_barrier_post(unsigned* bar, volatile LAS unsigned* st) {
    XcdBarrier b; b.bar = bar; b.x = xb_xcc_id(); b.st = st;
    if (threadIdx.x == 0) (void)xb_add(&bar[XB_XCNT(b.x)], 1u);
    return b;
}
__device__ __forceinline__ void xcd_barrier_complete(unsigned* bar, unsigned x, unsigned& nloc, unsigned& nx) {
    const unsigned G = gridDim.x * gridDim.y * gridDim.z;
    unsigned sum, cnt, mine, sp = 0u;
    for (;;) {
        sum = 0u; cnt = 0u; mine = 0u;
#pragma unroll
        for (unsigned j = 0; j < 16; ++j) { const unsigned c = xb_ld(&bar[XB_XCNT(j)]); sum += c; cnt += (c > 0u) ? 1u : 0u; mine = (j == x) ? c : mine; }
        if (sum == G) break;
        __builtin_amdgcn_s_sleep(1);
        if ((++sp & 255u) == 0u) { if (xb_ld(&bar[XB_TMO])) break; if (sp > XB_SPIN_CAP) { atomicAdd(&bar[XB_TMO], 1u); break; } }
    }
    nloc = mine > 0u ? mine : 1u; nx = cnt > 0u ? cnt : 1u;
}
__device__ __forceinline__ void xcd_barrier(unsigned* bar_, volatile LAS unsigned* st_) {
    XcdBarrier b; b.bar = bar_; b.st = st_; b.x = xb_xcc_id();
    asm volatile("s_waitcnt vmcnt(0)" ::: "memory");
    __syncthreads();
    if (threadIdx.x == 0) {
        unsigned* bar = b.bar;
        __builtin_amdgcn_s_waitcnt(0);
        unsigned nloc = b.st[0], nx = b.st[1];
        if (nloc == 0u) { xcd_barrier_complete(bar, b.x, nloc, nx); b.st[0] = nloc; b.st[1] = nx; }
        const unsigned old = xb_add(&bar[XB_XSUB(b.x)], 1u);
        const unsigned gen = old / nloc;
        if (old + 1u == (gen + 1u) * nloc) {
            __builtin_amdgcn_fence(__ATOMIC_RELEASE, "agent");
            asm volatile("s_waitcnt vmcnt(0)" ::: "memory");
            const unsigned og = xb_add(&bar[XB_TOP], 1u);
            const unsigned tg = og / nx;
            if (og + 1u == (tg + 1u) * nx) xb_add(&bar[XB_TOPGEN], 1u);
            else XB_SPIN(xb_ld(&bar[XB_TOPGEN]) == tg, bar);
            __builtin_amdgcn_fence(__ATOMIC_ACQUIRE, "agent");
            xb_add(&bar[XB_XGEN(b.x)], 1u);
            asm volatile("s_waitcnt vmcnt(0)" ::: "memory");
        } else {
            XB_SPIN(xb_ld(&bar[XB_XGEN(b.x)]) == gen, bar);
            __builtin_amdgcn_fence(__ATOMIC_ACQUIRE, "agent");
            asm volatile("s_waitcnt vmcnt(0)" ::: "memory");
        }
    }
    __syncthreads();
}

constexpr int NPHASE = 16;
__global__ void __launch_bounds__(512, 2) fwd_mega(const float* p_x, const float* p_c, const float* p_ctx, const float* p_cctx, const float* p_wada, const float* p_bada, const float* p_ng,
        const float* p_win, const float* p_wf, const float* p_wp, const float* p_ps, const float* p_dl, const float* p_wuf, const float* p_wup, const float* p_wur, const float* p_wout,
        const float* p_fg, float* p_out, unsigned char* p_ws, int ph_lo, int ph_hi) {
    Args a{p_x, p_c, p_ctx, p_cctx, p_wada, p_bada, p_ng, p_win, p_wf, p_wp, p_ps, p_dl, p_wuf, p_wup, p_wur, p_wout, p_fg, p_out, p_ws, ph_lo, ph_hi};
    extern __shared__ __attribute__((aligned(16))) unsigned char lds_raw[];
    cg::grid_group grid = cg::this_grid();
    Frame F; F.lds = (LAS unsigned char*)lds_raw; F.tid = threadIdx.x; F.lane = F.tid & 63; F.wave = __builtin_amdgcn_readfirstlane(F.tid >> 6); F.G = gridDim.x; F.bid = blockIdx.x;
#define REFRAME() do { int _t = threadIdx.x; asm volatile("" : "+v"(_t)); { unsigned long long _z = 0; asm volatile("" : "+s"(_z)); a.ws = p_ws + _z; } F.tid = _t; F.lane = _t & 63; F.wave = __builtin_amdgcn_readfirstlane(_t >> 6); } while (0)
    const int lo = a.ph_lo, hi = a.ph_hi;
    volatile LAS unsigned* xst = (volatile LAS unsigned*)(F.lds + LDS_BYTES - 64);
    if (F.tid < 4) xst[F.tid] = 0u;
    __syncthreads();
    (void)xcd_barrier_post((unsigned*)(a.ws + WS_BAR), xst);
#define IN(k) (lo <= (k) && (k) < hi)
#define SEAM(k) do { if (IN(k) && IN((k) + 1)) { if (lo < 0) grid.sync(); else xcd_barrier((unsigned*)(a.ws + WS_BAR), (volatile LAS unsigned*)(F.lds + LDS_BYTES - 64)); } } while (0)
    if (IN(0)) {
#ifndef NO_P0
        p0_mod(a, F); REFRAME(); p0_misc(a, F); REFRAME(); weights_layer(a, F, 0, 31, F.bid, F.G);
#endif
    }
    SEAM(0);
    for (int l = 0; l < DEPTH; ++l) {
        const int p = 1 + 7 * l;
        if (IN(p)) {
#ifndef NO_PA
            REFRAME(); if (l == 0) prenorm(a, F, l, 0); else { prenorm_b16(a, F, l); REFRAME(); prenorm(a, F, l, MLAT); } if (l == 1) { __syncthreads(); REFRAME(); weights_layer(a, F, 1, 31, F.bid, F.G); }
#endif
        }
        SEAM(p);
        if (IN(p + 1)) {
#ifndef NO_PB
            pg8::Gemm g{(const bf16_t*)(a.ws + WS_XN), (const bf16_t*)(a.ws + WS_WIN), LDX, LDX, MTOT, INW, D};
            pg8::StaticOrder S;
            if (l == DEPTH - 1) { S.init(MLAT, INW, F.G, F.bid, WGM_IN); S.add_extra(MLAT / 256, OFF_K / 256, (MCTX / 256) * ((OFF_RG - OFF_K) / 256)); }
            else S.init(MTOT, INW, F.G, F.bid, WGM_IN);
            pg8::EpiInProj E{(bf16_t*)(a.ws + WS_PROJ)};
            pg8::gemm_phase<pg8::EpiInProj>(F.lds, g, S, E);
#endif
        }
        SEAM(p + 1);
        if (IN(p + 2)) {
#ifndef NO_KV
            REFRAME(); kv_phase(a, F, l);
#endif
#ifndef NO_F1
            REFRAME(); fourier1(a, F, l);
#endif
#ifndef NO_POOL
            REFRAME(); pool_phase(a, F, l);
#endif
        }
        SEAM(p + 2);
        if (IN(p + 3)) {
#ifndef NO_SCAN
            REFRAME(); scan_phase(a, F, l);
#endif
#ifndef NO_F2
            REFRAME(); fourier2(a, F, l);
#endif
#ifndef NO_RO
            if (l == 0) { REFRAME(); retout_phase(a, F, l, 1, 0); }
#endif
        }
        SEAM(p + 3);
        constexpr int NCTXU = (MCTX / 256) * (D / 256);
        const bool split = (l == 0) && (F.G >= 4 * NCTXU);
        if (IN(p + 4)) {
#ifndef NO_RO
            if (split && F.bid < NCTXU) {
                pg8::Gemm g{(const bf16_t*)(a.ws + WS_XN) + (size_t)MLAT * LDX, (const bf16_t*)(a.ws + WS_WUP), LDX, LDX, MCTX, D, D};
                pg8::StaticOrder S; S.init(MCTX, D, NCTXU, F.bid, 4);
                pg8::EpiUp E{(const bf16_t*)(a.ws + WS_PROJ) + (size_t)MLAT * INW, (bf16_t*)(a.ws + WS_MERGED) + (size_t)MLAT * LDX};
                pg8::gemm_phase<pg8::EpiUp>(F.lds, g, S, E);
            } else { REFRAME(); retout_phase(a, F, l, split ? 2 : 0, NCTXU); }
#endif
        }
        SEAM(p + 4);
        const int Mrows = (l == 0) ? MTOT : MLAT;
        if (IN(p + 5)) {
#ifndef NO_PF
            const int Mup = split ? MLAT : Mrows;
            pg8::Gemm g{(const bf16_t*)(a.ws + WS_XN), (const bf16_t*)(a.ws + WS_WUP), LDX, LDX, Mup, D, D};
            pg8::StaticOrder S; S.init(Mup, D, F.G, F.bid, WGM_UP);
            pg8::EpiUp E{(const bf16_t*)(a.ws + WS_PROJ), (bf16_t*)(a.ws + WS_MERGED)};
            pg8::gemm_phase<pg8::EpiUp>(F.lds, g, S, E);
#endif
        }
        SEAM(p + 5);
        if (IN(p + 6)) {
#ifndef NO_PG
            pg8::Gemm g{(const bf16_t*)(a.ws + WS_MERGED), (const bf16_t*)(a.ws + WS_WOUT), LDX, LDX, Mrows, D, D};
            pg8::StaticOrder S; S.init(Mrows, D, F.G, F.bid, WGM_OUT);
            pg8::EpiOut E{(l == 0) ? a.x : nullptr, (l == 0) ? nullptr : (const bf16_t*)a.out, (l == DEPTH - 1) ? (bf16_t*)(a.ws + WS_XFIN) : (bf16_t*)a.out, a.ctx, (float*)(a.ws + WS_CTX1),
                          (const float*)(a.ws + WS_MOD) + (size_t)l * 5 * 6144};
            pg8::gemm_phase<pg8::EpiOut>(F.lds, g, S, E);
#endif
        }
        SEAM(p + 6);
    }
    if (IN(15)) { REFRAME(); final_norm(a, F); }
#undef IN
#undef SEAM
}

extern "C" void kernel_launch(void* const* d_in, const int* in_sizes, int n_in, void* d_out, int out_size, void* d_ws, size_t ws_size, hipStream_t stream) {
    static int grid = 0;
    if (grid == 0) {
        if (n_in != 17 || out_size != MLAT * D || ws_size < WS_END) { fprintf(stderr, "kernel_launch: unexpected shapes: n_in %d out %d ws %zu (need >= %zu)\n", n_in, out_size, ws_size, (size_t)WS_END); grid = -1; return; }
        int dev = 0, cus = 0, per_cu = 0;
        if (hipGetDevice(&dev) != hipSuccess || hipDeviceGetAttribute(&cus, hipDeviceAttributeMultiprocessorCount, dev) != hipSuccess) { grid = -1; return; }
        if (hipFuncSetAttribute((const void*)fwd_mega, hipFuncAttributeMaxDynamicSharedMemorySize, LDS_BYTES) != hipSuccess) { fprintf(stderr, "kernel_launch: hipFuncSetAttribute failed\n"); grid = -1; return; }
        if (hipOccupancyMaxActiveBlocksPerMultiprocessor(&per_cu, (const void*)fwd_mega, 512, LDS_BYTES) != hipSuccess || per_cu < 1) { fprintf(stderr, "kernel_launch: occupancy query gave %d\n", per_cu); (void)hipGetLastError(); grid = -1; return; }
        grid = cus * per_cu;
        fprintf(stderr, "kernel_launch: grid %d (cus %d x %d)\n", grid, cus, per_cu);
    }
    if (grid < 0) return;
    Args a{};
    a.x = (const float*)d_in[0]; a.c = (const float*)d_in[1]; a.ctx = (const float*)d_in[2]; a.c_ctx = (const float*)d_in[3]; a.w_ada = (const float*)d_in[4]; a.b_ada = (const float*)d_in[5];
    a.norm_g = (const float*)d_in[6]; a.w_in = (const float*)d_in[7]; a.w_fourier = (const float*)d_in[8]; a.w_pool = (const float*)d_in[9]; a.pool_scale = (const float*)d_in[10];
    a.decay_logit = (const float*)d_in[11]; a.w_up_f = (const float*)d_in[12]; a.w_up_p = (const float*)d_in[13]; a.w_up_r = (const float*)d_in[14]; a.w_out = (const float*)d_in[15];
    a.final_g = (const float*)d_in[16]; a.out = (float*)d_out; a.ws = (unsigned char*)d_ws;
    a.ph_lo = 0; a.ph_hi = NPHASE;
    if (hipMemsetAsync((unsigned char*)d_ws + WS_BAR, 0, XCD_BAR_WORDS * 4, stream) != hipSuccess) { fprintf(stderr, "kernel_launch: memset failed\n"); return; }
    void* args[] = {&a.x, &a.c, &a.ctx, &a.c_ctx, &a.w_ada, &a.b_ada, &a.norm_g, &a.w_in, &a.w_fourier, &a.w_pool, &a.pool_scale, &a.decay_logit, &a.w_up_f, &a.w_up_p, &a.w_up_r, &a.w_out,
                    &a.final_g, &a.out, &a.ws, &a.ph_lo, &a.ph_hi};
    hipError_t e = hipLaunchCooperativeKernel((const void*)fwd_mega, dim3(grid), dim3(512), args, LDS_BYTES, stream);
    if (e != hipSuccess) fprintf(stderr, "kernel_launch: cooperative launch failed: %s (grid %d)\n", hipGetErrorString(e), grid);
}
```
